# Optimizing an MI355X kernel written in HIP

```python
import math
import jax, jax.numpy as jnp
from jax import lax
import numpy as np

D_MODEL = 1024
BATCH = 4
SEQ = 4096
DEPTH = 2

S5_WIDTH = D_MODEL // 2
S5_GROUP = 16
S5_GROUPS = S5_WIDTH // S5_GROUP
S5_STATE = 64
FOX_HEAD_DIM = 64
FOX_HEADS = (D_MODEL - S5_WIDTH) // FOX_HEAD_DIM
FOX_WIDTH = FOX_HEADS * FOX_HEAD_DIM
Q_BLOCK = 128
EVEN_IN = S5_WIDTH + 3 * FOX_WIDTH + FOX_HEADS
EVEN_MIX = S5_WIDTH + FOX_WIDTH
POOL_WIDTH = D_MODEL // 2
POOL_WINDOWS = (2, 4, 8, 16)
POOL_GROUPS = len(POOL_WINDOWS)
POOL_GROUP_DIM = POOL_WIDTH // POOL_GROUPS
SGU_WIDTH = D_MODEL // 2
SGU_GROUPS = 4
SGU_GROUP_DIM = SGU_WIDTH // SGU_GROUPS
CHUNK = 128
ODD_IN = POOL_WIDTH + 2 * SGU_WIDTH
ODD_MIX = POOL_WIDTH + SGU_WIDTH
D_FF = 4 * D_MODEL
N_EVEN = (DEPTH + 1) // 2
N_ODD = DEPTH // 2
EPS = 1e-6

kernel_name = 'hybrid_s5_fox_pool_sgu'


def rms_norm(x, g):
    xf = x.astype(jnp.float32)
    y = xf * lax.rsqrt(jnp.mean(xf * xf, axis=-1, keepdims=True) + EPS)
    return (y * g.astype(jnp.float32)).astype(x.dtype)


def layer_norm(x, g, b):
    xf = x.astype(jnp.float32)
    mu = jnp.mean(xf, axis=-1, keepdims=True)
    xc = xf - mu
    y = xc * lax.rsqrt(jnp.mean(xc * xc, axis=-1, keepdims=True) + EPS)
    return (y * g.astype(jnp.float32) + b.astype(jnp.float32)).astype(x.dtype)


def _complex_scan_combine(e_i, e_j):
    ar_i, ai_i, br_i, bi_i = e_i
    ar_j, ai_j, br_j, bi_j = e_j
    ar = ar_j * ar_i - ai_j * ai_i
    ai = ar_j * ai_i + ai_j * ar_i
    br = ar_j * br_i - ai_j * bi_i + br_j
    bi = ar_j * bi_i + ai_j * br_i + bi_j
    return (ar, ai, br, bi)


def s5_mixer(u, lam_re, lam_im, log_dt, b_re, b_im, c_re, c_im, d, w_glu):
    f32 = jnp.float32
    bsz, L, _ = u.shape
    uf = u.astype(f32)
    dt = jnp.exp(log_dt.astype(f32))[:, None]
    lr = lam_re.astype(f32)
    li = lam_im.astype(f32)
    mag = jnp.exp(lr * dt)
    ab_re = mag * jnp.cos(li * dt)
    ab_im = mag * jnp.sin(li * dt)
    den = lr * lr + li * li
    nr = ab_re - 1.0
    ni = ab_im
    q_re = (nr * lr + ni * li) / den
    q_im = (ni * lr - nr * li) / den
    br = b_re.astype(f32)
    bi = b_im.astype(f32)
    bb_re = q_re[..., None] * br - q_im[..., None] * bi
    bb_im = q_re[..., None] * bi + q_im[..., None] * br
    ut = jnp.swapaxes(uf.reshape(bsz, L, S5_GROUPS, S5_GROUP), 0, 1)
    bu_re = jnp.einsum('lbgh,gph->lbgp', ut, bb_re)
    bu_im = jnp.einsum('lbgh,gph->lbgp', ut, bb_im)
    a_re = jnp.broadcast_to(ab_re[None, None], (L, 1, S5_GROUPS, S5_STATE))
    a_im = jnp.broadcast_to(ab_im[None, None], (L, 1, S5_GROUPS, S5_STATE))
    _, _, x_re, x_im = lax.associative_scan(_complex_scan_combine, (a_re, a_im, bu_re, bu_im), axis=0)
    y = (jnp.einsum('lbgp,ghp->lbgh', x_re, c_re.astype(f32))
         - jnp.einsum('lbgp,ghp->lbgh', x_im, c_im.astype(f32)))
    y = jnp.swapaxes(y, 0, 1).reshape(bsz, L, S5_WIDTH) + d.astype(f32) * uf
    y = jax.nn.gelu(y)
    y = y * jax.nn.sigmoid(y @ w_glu.astype(f32))
    return y.astype(u.dtype)


def fox_attention(q, k, v, f_logit, b_f):
    f32 = jnp.float32
    bsz, L, H, Dh = q.shape
    log_f = jax.nn.log_sigmoid(f_logit.astype(f32) + b_f.astype(f32))
    F = jnp.cumsum(log_f, axis=1)
    F_k = jnp.transpose(F, (0, 2, 1))
    n_blk = L // Q_BLOCK
    q_blocks = jnp.swapaxes(q.reshape(bsz, n_blk, Q_BLOCK, H, Dh), 0, 1)
    F_blocks = jnp.swapaxes(F_k.reshape(bsz, H, n_blk, Q_BLOCK), 0, 2).swapaxes(1, 2)
    k_pos = jnp.arange(L)
    scale = Dh ** -0.5

    def block(args):
        i, qi, Fi = args
        s = jnp.einsum('bqhd,bkhd->bhqk', qi, k).astype(f32) * scale
        s = s + (Fi[..., None] - F_k[:, :, None, :])
        q_pos = i * Q_BLOCK + jnp.arange(Q_BLOCK)
        mask = k_pos[None, :] <= q_pos[:, None]
        s = jnp.where(mask[None, None], s, -jnp.inf)
        p = jax.nn.softmax(s, axis=-1).astype(v.dtype)
        return jnp.einsum('bhqk,bkhd->bqhd', p, v)

    out = lax.map(block, (jnp.arange(n_blk), q_blocks, F_blocks))
    return jnp.swapaxes(out, 0, 1).reshape(bsz, L, H * Dh)


def pool_mixer(xc, pool_w, pool_scale):
    f32 = jnp.float32
    bsz, L, _ = xc.shape
    xg = xc.astype(f32).reshape(bsz, L, POOL_GROUPS, POOL_GROUP_DIM)
    csum = jnp.cumsum(xg, axis=1)
    t = jnp.arange(L, dtype=f32)
    outs = []
    for g, w in enumerate(POOL_WINDOWS):
        cg = csum[:, :, g]
        lagged = jnp.pad(cg, ((0, 0), (w, 0), (0, 0)))[:, :L]
        cnt = jnp.minimum(t + 1.0, float(w))[None, :, None]
        outs.append((cg - lagged) / cnt - xg[:, :, g])
    pooled = jnp.stack(outs, axis=2)
    y = jnp.einsum('blgc,gcd->blgd', pooled, pool_w.astype(f32)).reshape(bsz, L, POOL_WIDTH)
    return (y * pool_scale.astype(f32)).astype(xc.dtype)


def sgu_mixer(u, v, ln_g, ln_b, w_s, b_s):
    bsz, L, _ = u.shape
    u = jax.nn.gelu(u)
    v = layer_norm(jax.nn.gelu(v), ln_g, ln_b)
    n_chunk = L // CHUNK
    vg = v.reshape(bsz, n_chunk, CHUNK, SGU_GROUPS, SGU_GROUP_DIM)
    causal = jnp.tril(jnp.ones((CHUNK, CHUNK), dtype=bool))
    ws = jnp.where(causal[None], w_s, jnp.zeros_like(w_s))
    mixed = jnp.einsum('gts,bnsgc->bntgc', ws, vg) + jnp.transpose(b_s)[None, None, :, :, None]
    return u * mixed.reshape(bsz, L, SGU_WIDTH)


def even_mixer(h, w_in, lam_re, lam_im, log_dt, b_re, b_im, c_re, c_im, d, w_glu, b_f, w_out):
    bsz, L, _ = h.shape
    z = h @ w_in
    s1 = S5_WIDTH
    s2 = s1 + FOX_WIDTH
    s3 = s2 + FOX_WIDTH
    s4 = s3 + FOX_WIDTH
    u, q, k, v, fl = z[..., :s1], z[..., s1:s2], z[..., s2:s3], z[..., s3:s4], z[..., s4:]
    y_a = s5_mixer(u, lam_re, lam_im, log_dt, b_re, b_im, c_re, c_im, d, w_glu)
    shp = (bsz, L, FOX_HEADS, FOX_HEAD_DIM)
    y_b = fox_attention(q.reshape(shp), k.reshape(shp), v.reshape(shp), fl, b_f)
    return jnp.concatenate([y_a, y_b], axis=-1) @ w_out


def odd_mixer(h, w_in, pool_w, pool_scale, ln_g, ln_b, w_s, b_s, w_out):
    z = h @ w_in
    s1 = POOL_WIDTH
    s2 = s1 + SGU_WIDTH
    xc, u, v = z[..., :s1], z[..., s1:s2], z[..., s2:]
    y_c = pool_mixer(xc, pool_w, pool_scale)
    y_d = sgu_mixer(u, v, ln_g, ln_b, w_s, b_s)
    return jnp.concatenate([y_c, y_d], axis=-1) @ w_out


def sq_relu_mlp(h, w1, w2):
    return jnp.square(jax.nn.relu(h @ w1)) @ w2


def setup_inputs(seed: int = 0) -> dict:
    key = jax.random.key(seed)
    ks = jax.random.split(key, 32)
    f32 = jnp.float32

    def nrm(k, shape, scale):
        return scale * jax.random.normal(k, shape, f32)

    G, P, H = S5_GROUPS, S5_STATE, S5_GROUP
    return {
        'x': nrm(ks[0], (BATCH, SEQ, D_MODEL), 1.0),
        'mix_pre_g': 1.0 + nrm(ks[1], (DEPTH, D_MODEL), 0.02),
        'mix_post_g': 1.0 + nrm(ks[2], (DEPTH, D_MODEL), 0.02),
        'mlp_pre_g': 1.0 + nrm(ks[3], (DEPTH, D_MODEL), 0.02),
        'mlp_post_g': 1.0 + nrm(ks[4], (DEPTH, D_MODEL), 0.02),
        'w_in_even': nrm(ks[5], (N_EVEN, D_MODEL, EVEN_IN), D_MODEL ** -0.5),
        's5_lam_re': -0.5 + nrm(ks[6], (N_EVEN, G, P), 0.01),
        's5_lam_im': jnp.pi * jnp.arange(P, dtype=f32) + nrm(ks[7], (N_EVEN, G, P), 0.01),
        's5_log_dt': jax.random.uniform(ks[8], (N_EVEN, G), f32, math.log(1e-3), math.log(1e-1)),
        's5_b_re': nrm(ks[9], (N_EVEN, G, P, H), (2 * H) ** -0.5),
        's5_b_im': nrm(ks[10], (N_EVEN, G, P, H), (2 * H) ** -0.5),
        's5_c_re': nrm(ks[11], (N_EVEN, G, H, P), P ** -0.5),
        's5_c_im': nrm(ks[12], (N_EVEN, G, H, P), P ** -0.5),
        's5_d': nrm(ks[13], (N_EVEN, S5_WIDTH), 1.0),
        's5_w_glu': nrm(ks[14], (N_EVEN, S5_WIDTH, S5_WIDTH), S5_WIDTH ** -0.5),
        'fox_b_f': jax.random.uniform(ks[15], (N_EVEN, FOX_HEADS), f32, 0.0, 3.0),
        'w_out_even': nrm(ks[16], (N_EVEN, EVEN_MIX, D_MODEL), EVEN_MIX ** -0.5),
        'w_in_odd': nrm(ks[17], (N_ODD, D_MODEL, ODD_IN), D_MODEL ** -0.5),
        'pool_w': nrm(ks[18], (N_ODD, POOL_GROUPS, POOL_GROUP_DIM, POOL_GROUP_DIM), POOL_GROUP_DIM ** -0.5),
        'pool_scale': 1.0 + nrm(ks[19], (N_ODD, POOL_WIDTH), 0.02),
        'sgu_ln_g': 1.0 + nrm(ks[20], (N_ODD, SGU_WIDTH), 0.02),
        'sgu_ln_b': nrm(ks[21], (N_ODD, SGU_WIDTH), 0.02),
        'sgu_w_s': nrm(ks[22], (N_ODD, SGU_GROUPS, CHUNK, CHUNK), CHUNK ** -0.5),
        'sgu_b_s': 1.0 + nrm(ks[23], (N_ODD, SGU_GROUPS, CHUNK), 0.1),
        'w_out_odd': nrm(ks[24], (N_ODD, ODD_MIX, D_MODEL), ODD_MIX ** -0.5),
        'mlp_w1': nrm(ks[25], (DEPTH, D_MODEL, D_FF), D_MODEL ** -0.5),
        'mlp_w2': nrm(ks[26], (DEPTH, D_FF, D_MODEL), D_FF ** -0.5),
    }


def reference(x, mix_pre_g, mix_post_g, mlp_pre_g, mlp_post_g,
              w_in_even, s5_lam_re, s5_lam_im, s5_log_dt, s5_b_re, s5_b_im, s5_c_re, s5_c_im,
              s5_d, s5_w_glu, fox_b_f, w_out_even,
              w_in_odd, pool_w, pool_scale, sgu_ln_g, sgu_ln_b, sgu_w_s, sgu_b_s, w_out_odd,
              mlp_w1, mlp_w2):
    for l in range(DEPTH):
        h = rms_norm(x, mix_pre_g[l])
        if l % 2 == 0:
            e = l // 2
            y = even_mixer(h, w_in_even[e], s5_lam_re[e], s5_lam_im[e], s5_log_dt[e],
                           s5_b_re[e], s5_b_im[e], s5_c_re[e], s5_c_im[e], s5_d[e], s5_w_glu[e],
                           fox_b_f[e], w_out_even[e])
        else:
            o = l // 2
            y = odd_mixer(h, w_in_odd[o], pool_w[o], pool_scale[o], sgu_ln_g[o], sgu_ln_b[o],
                          sgu_w_s[o], sgu_b_s[o], w_out_odd[o])
        x = x + rms_norm(y, mix_post_g[l])
        h = rms_norm(x, mlp_pre_g[l])
        x = x + rms_norm(sq_relu_mlp(h, mlp_w1[l], mlp_w2[l]), mlp_post_g[l])
    return x
```

```cpp
#include <hip/hip_runtime.h>
#include <hip/hip_bf16.h>
#include <cstdio>
#include <cstdint>
#include <cmath>
namespace pg8 {
#define PG8_LAS __attribute__((address_space(3)))
typedef unsigned short bf16_t;
typedef short bf16x8 __attribute__((ext_vector_type(8)));
typedef float f32x4 __attribute__((ext_vector_type(4)));
typedef unsigned u32x4 __attribute__((ext_vector_type(4)));
constexpr int BM = 256, BK = 64, HALF = 128, HTB = HALF * BK * 2  , STAGE_BYTES = 8 * HTB, NXCD = 8, WGM = 8;

__host__ __device__ __forceinline__ int lds_byte(int r, int c) { const int st = (r >> 4) * 2 + (c >> 5), rr = r & 15, cc = c & 31, ob = rr * 64 + cc * 2; return st * 1024 + (ob ^ (((ob >> 9) & 1) << 5)); }
__host__ __device__ __forceinline__ void stage_rc(int b, int& R, int& C) { const int st = b / 1024, sb = b % 1024, swz = sb ^ (((sb >> 9) & 1) << 5); R = (st >> 1) * 16 + swz / 64; C = (st & 1) * 32 + (swz % 64) / 2; }
__host__ __device__ __forceinline__ int perm32(int rho) { const int n = rho >> 4, i = rho & 15; return 8 * (i >> 2) + 4 * n + (i & 3); }

struct Unit { int pm, pn; size_t aoff, boff; };
struct Gemm { const bf16_t* A; const bf16_t* Bt; int lda, ldb, K; };

struct StaticOrder {
    int nM, nN, nwg, G, c, lda, ldb;
    __host__ __device__ void init(int M, int N, int G_, int c_, int lda_, int ldb_) { nM = M / BM; nN = N / BM; nwg = nM * nN; G = G_; c = c_; lda = lda_; ldb = ldb_; }
    __host__ __device__ bool next(int i, Unit& u) const {
        const long L = (long)i * G + c; if (L >= nwg) return false;
        int wgid = (int)L; { const int q = nwg / NXCD, r = nwg % NXCD, xcd = wgid % NXCD, off = wgid / NXCD; wgid = (xcd < r ? xcd * (q + 1) : r * (q + 1) + (xcd - r) * q) + off; }
        const int nig = WGM * nN, gid = wgid / nig, fm = gid * WGM, gsz = (nM - fm) < WGM ? (nM - fm) : WGM;
        u.pm = fm + ((wgid % nig) % gsz); u.pn = (wgid % nig) / gsz;
        u.aoff = (size_t)u.pm * BM * lda * 2; u.boff = (size_t)u.pn * BM * ldb * 2; return true;
    }
    __device__ __forceinline__ void a_ready(const Unit&) const {}
    __device__ __forceinline__ void done(const Unit&) const {}
};
template <int KIND> struct GroupOrder {
    int n, G, c, ldb;
    __device__ __forceinline__ bool next(int i, Unit& u) const {
        const long Ll = (long)i * G + c; if (c < 0 || Ll >= n) return false; const int L = (int)Ll;
        if (KIND == 0) { u.pm = L; u.pn = 0; u.aoff = (size_t)L * 256 * 384 * 2; u.boff = (size_t)(L >> 2) * 256 * ldb * 2; }
        else if (KIND == 1) { u.pm = L >> 1; u.pn = L & 1; u.aoff = (size_t)u.pm * 256 * 512 * 2; u.boff = (size_t)u.pn * 256 * 512 * 2; }
        else if (KIND == 2) { u.pm = L >> 1; u.pn = L & 1; u.aoff = ((size_t)u.pm * 256 * 512 + u.pn * 256) * 2; u.boff = (size_t)u.pn * 65536 * 2; }
        else { u.pm = L & 1; u.pn = L >> 1; u.aoff = (size_t)u.pm * 65536 * 2; u.boff = ((size_t)u.pn * 256 * 512 + u.pm * 256) * 2; }
        return true;
    }
    __device__ __forceinline__ void a_ready(const Unit&) const {}
    __device__ __forceinline__ void done(const Unit&) const {}
};

__device__ __forceinline__ unsigned cvt_pk_bf16(float lo, float hi) { unsigned r; asm volatile("v_cvt_pk_bf16_f32 %0, %1, %2" : "=v"(r) : "v"(lo), "v"(hi)); return r; }
__device__ __forceinline__ float bflo(unsigned w) { return __uint_as_float(w << 16); }
__device__ __forceinline__ float bfhi(unsigned w) { return __uint_as_float(w & 0xffff0000u); }
__device__ __forceinline__ float gelu_t(float x) {
    const float z = x * (1.0f + 0.044715f * x * x); const float e = __builtin_amdgcn_exp2f(-2.302208198f * z); return x * __builtin_amdgcn_rcpf(1.0f + e); }
__device__ __forceinline__ float sigm(float a) { return __builtin_amdgcn_rcpf(1.0f + __builtin_amdgcn_exp2f(-1.4426950409f * a)); }
__device__ __forceinline__ u32x4 pack8(const f32x4& a, const f32x4& b) { u32x4 w; w.x = cvt_pk_bf16(a[0], a[1]); w.y = cvt_pk_bf16(a[2], a[3]); w.z = cvt_pk_bf16(b[0], b[1]); w.w = cvt_pk_bf16(b[2], b[3]); return w; }

#define EPI_LOOP_BEGIN  int fr_ = fr, fq_ = fq; asm volatile("" : "+v"(fr_), "+v"(fq_)); _Pragma("unroll") for (int ai = 0; ai < 2; ++ai) _Pragma("unroll") for (int m = 0; m < 4; ++m) { const int rl = ai * HALF + wr * 64 + m * 16 + fr_; \
                        _Pragma("unroll") for (int bj = 0; bj < 2; ++bj) { const int cl = bj * HALF + wc * 32 + 8 * fq_; f32x4 v0 = acc[ai][bj][m][0], v1 = acc[ai][bj][m][1];
#define EPI_LOOP_END    } __builtin_amdgcn_sched_barrier(0); }

template <int ACT> struct EpiBf16 {
    static constexpr bool PERM = true, AFTER_DRAIN = false;
    bf16_t* O; int ldc;
    __device__ __forceinline__ void operator()(const f32x4 (&acc)[2][2][4][2], const Unit& u, int wr, int wc, int fr, int fq) const {
        EPI_LOOP_BEGIN
            if (ACT == 1) { _Pragma("unroll") for (int e = 0; e < 4; ++e) { const float a = fmaxf(v0[e], 0.f), b = fmaxf(v1[e], 0.f); v0[e] = a * a; v1[e] = b * b; } }
            *(u32x4*)(O + (unsigned)(u.pm * BM + rl) * ldc + u.pn * BM + cl) = pack8(v0, v1);
        EPI_LOOP_END
    }
};
struct EpiInEven {
    static constexpr bool PERM = true, AFTER_DRAIN = false;
    bf16_t* U; bf16_t* Q; float c2;
    __device__ __forceinline__ void operator()(const f32x4 (&acc)[2][2][4][2], const Unit& u, int wr, int wc, int fr, int fq) const {
        const int pn = u.pn;
        EPI_LOOP_BEGIN
            const int row = u.pm * BM + rl;
            if (pn < 2) { const int b = row >> 12, ts = row & 4095, c = ts >> 4, t = ts & 15, col = pn * BM + cl, g = col >> 4, h0 = col & 15;
                *(u32x4*)(U + ((unsigned)(g * 1024 + b * 256 + c) * 384 + t * 16 + h0)) = pack8(v0, v1); }
            else { const int tsel = (pn - 2) >> 1, col = ((pn - 2) & 1) * BM + cl; if (tsel == 0) { v0 = v0 * c2; v1 = v1 * c2; }
                *(u32x4*)(Q + (unsigned)tsel * ((unsigned)16384 * 512) + (unsigned)row * 512 + col) = pack8(v0, v1); }
        EPI_LOOP_END
    }
};
struct EpiS5P1 {
    static constexpr bool PERM = false, AFTER_DRAIN = false;
    float* S;
    __device__ __forceinline__ void operator()(const f32x4 (&acc)[2][2][4][2], const Unit& u, int wr, int wc, int fr, int fq) const {
        int fr_ = fr, fq_ = fq; asm volatile("" : "+v"(fr_), "+v"(fq_));
#pragma unroll
        for (int ai = 0; ai < 2; ++ai)
#pragma unroll
            for (int m = 0; m < 4; ++m) { const int row = u.pm * BM + ai * HALF + wr * 64 + m * 16 + fr_;
#pragma unroll
                for (int n = 0; n < 2; ++n) *(f32x4*)(S + (unsigned)row * 128 + wc * 32 + 16 * n + 4 * fq_) = acc[ai][0][m][n]; }
    }
};
struct EpiS5P2 {
    static constexpr bool PERM = true, AFTER_DRAIN = false;
    bf16_t* GY;
    __device__ __forceinline__ void operator()(const f32x4 (&acc)[2][2][4][2], const Unit& u, int wr, int wc, int fr, int fq) const {
        int lo_ = fr * 8192 + (fq >> 1) * 512 + (fq & 1) * 8; asm volatile("" : "+v"(lo_));
        bf16_t* base = GY + ((unsigned)(u.pm & 3) * 4096u * 512u + (unsigned)(u.pm >> 2) * 16u + (unsigned)wr * 64u * 8192u + (unsigned)wc * 2u * 512u);
#pragma unroll
        for (int ai = 0; ai < 2; ++ai)
#pragma unroll
            for (int m = 0; m < 4; ++m) {
#pragma unroll
                for (int bj = 0; bj < 2; ++bj) { f32x4 v0 = acc[ai][bj][m][0], v1 = acc[ai][bj][m][1];
#pragma unroll
                    for (int e = 0; e < 4; ++e) { v0[e] = gelu_t(v0[e]); v1[e] = gelu_t(v1[e]); }
                    *(u32x4*)(base + (unsigned)((ai * HALF + m * 16) * 8192 + bj * 8 * 512) + lo_) = pack8(v0, v1); }
                __builtin_amdgcn_sched_barrier(0); }
    }
};
struct EpiGLU {
    static constexpr bool PERM = true, AFTER_DRAIN = false;
    const bf16_t* GY; bf16_t* MIX;
    __device__ __forceinline__ void operator()(const f32x4 (&acc)[2][2][4][2], const Unit& u, int wr, int wc, int fr, int fq) const {
        EPI_LOOP_BEGIN
            const unsigned row = (unsigned)u.pm * BM + rl; const int col = u.pn * BM + cl; const u32x4 gy = *(const u32x4*)(GY + row * 512 + col);
            v0[0] = bflo(gy.x) * sigm(v0[0]); v0[1] = bfhi(gy.x) * sigm(v0[1]); v0[2] = bflo(gy.y) * sigm(v0[2]); v0[3] = bfhi(gy.y) * sigm(v0[3]);
            v1[0] = bflo(gy.z) * sigm(v1[0]); v1[1] = bfhi(gy.z) * sigm(v1[1]); v1[2] = bflo(gy.w) * sigm(v1[2]); v1[3] = bfhi(gy.w) * sigm(v1[3]);
            *(u32x4*)(MIX + row * 1024 + col) = pack8(v0, v1);
        EPI_LOOP_END
    }
};
struct EpiInOdd {
    static constexpr bool PERM = true, AFTER_DRAIN = false;
    bf16_t* XC;
    __device__ __forceinline__ void operator()(const f32x4 (&acc)[2][2][4][2], const Unit& u, int wr, int wc, int fr, int fq) const {
        const int tsel = u.pn >> 1;
        EPI_LOOP_BEGIN
            const unsigned row = (unsigned)u.pm * BM + rl; const int col = (u.pn & 1) * BM + cl;
            if (tsel > 0) { _Pragma("unroll") for (int e = 0; e < 4; ++e) { v0[e] = gelu_t(v0[e]); v1[e] = gelu_t(v1[e]); } }
            *(u32x4*)(XC + (unsigned)tsel * ((unsigned)16384 * 512) + row * 512 + col) = pack8(v0, v1);
        EPI_LOOP_END
    }
};
struct EpiPool {
    static constexpr bool PERM = true, AFTER_DRAIN = false;
    const float* scale; bf16_t* MIX;
    __device__ __forceinline__ void operator()(const f32x4 (&acc)[2][2][4][2], const Unit& u, int wr, int wc, int fr, int fq) const {
        EPI_LOOP_BEGIN
            const unsigned row = (unsigned)u.pm * BM + rl; const int col = u.pn * BM + cl;
            v0 = v0 * *(const f32x4*)(scale + col); v1 = v1 * *(const f32x4*)(scale + col + 4);
            *(u32x4*)(MIX + row * 1024 + col) = pack8(v0, v1);
        EPI_LOOP_END
    }
};
struct EpiSGU {
    static constexpr bool PERM = true, AFTER_DRAIN = false;
    const float* bs; const bf16_t* GU; bf16_t* MIX;
    __device__ __forceinline__ void operator()(const f32x4 (&acc)[2][2][4][2], const Unit& u, int wr, int wc, int fr, int fq) const {
        EPI_LOOP_BEGIN
            const int g = 2 * u.pm + (rl >> 7), t = rl & 127, cn = u.pn * 2 + (cl >> 7), c = cl & 127; const unsigned tok = (unsigned)cn * 128 + t; const int ch = g * 128 + c;
            const float bias = bs[g * 128 + t]; const u32x4 gu = *(const u32x4*)(GU + tok * 512 + ch);
            v0[0] = (v0[0] + bias) * bflo(gu.x); v0[1] = (v0[1] + bias) * bfhi(gu.x); v0[2] = (v0[2] + bias) * bflo(gu.y); v0[3] = (v0[3] + bias) * bfhi(gu.y);
            v1[0] = (v1[0] + bias) * bflo(gu.z); v1[1] = (v1[1] + bias) * bfhi(gu.z); v1[2] = (v1[2] + bias) * bflo(gu.w); v1[3] = (v1[3] + bias) * bfhi(gu.w);
            *(u32x4*)(MIX + tok * 1024 + 512 + ch) = pack8(v0, v1);
        EPI_LOOP_END
    }
};

template <class Epi, class Sched, bool ALIGN_EPI = false, bool SP2 = false>
__device__ __forceinline__ void gemm_phase(PG8_LAS unsigned char* lds, const Gemm g, const Sched& S, const Epi& E) {
    int tid_ = threadIdx.x; asm volatile("" : "+v"(tid_));
    const int tid = tid_, wid = __builtin_amdgcn_readfirstlane(tid >> 6), lane = tid & 63, wr = wid >> 2, wc = wid & 3, fr = lane & 15, fq = lane >> 4;
    const int K = g.K, nt = K / BK;
    unsigned voffA[2], voffB[2];
#pragma unroll
    for (int i = 0; i < 2; ++i) { int R, C; stage_rc(tid * 16 + i * 8192, R, C); const int Rb = Epi::PERM ? ((R & ~31) + perm32(R & 31)) : R;
        voffA[i] = (unsigned)(R * g.lda + C) * 2u; voffB[i] = (unsigned)(Rb * g.ldb + C) * 2u; }
    const size_t kstep = (size_t)(BK * 2);
    const size_t hstepA = (size_t)HALF * g.lda * 2, hstepB = (size_t)HALF * g.ldb * 2;
    const unsigned ldsw = (unsigned)wid * 1024u;
    const int aoff = lds_byte(wr * 64 + fr, fq * 8), boff = lds_byte(wc * 32 + fr, fq * 8);
#define PG8_SA(b, h) (((b) * 2 + (h)) * HTB)
#define PG8_SB(b, h) ((4 + (b) * 2 + (h)) * HTB)
#define PG8_STAGE(bufoff, gbase, voff) do { _Pragma("unroll") for (int _i = 0; _i < 2; ++_i) \
        __builtin_amdgcn_global_load_lds((const unsigned*)((const char*)(gbase) + (voff)[_i]), (PG8_LAS unsigned*)(lds + (bufoff) + ldsw + _i * 8192), 16, 0, 0); } while (0)
#define PG8_LDA(dst, b, h) do { _Pragma("unroll") for (int m = 0; m < 4; ++m) _Pragma("unroll") for (int k = 0; k < 2; ++k) dst[m][k] = *(const PG8_LAS bf16x8*)(lds + PG8_SA(b, h) + aoff + m * 2048 + k * 1024); } while (0)
#define PG8_LDB(dst, b, h) do { _Pragma("unroll") for (int n = 0; n < 2; ++n) _Pragma("unroll") for (int k = 0; k < 2; ++k) dst[n][k] = *(const PG8_LAS bf16x8*)(lds + PG8_SB(b, h) + boff + n * 2048 + k * 1024); } while (0)
#define PG8_MMA(ai, bj, At, Bt) do { __builtin_amdgcn_s_setprio(1); _Pragma("unroll") for (int m = 0; m < 4; ++m) _Pragma("unroll") for (int n = 0; n < 2; ++n) _Pragma("unroll") for (int k = 0; k < 2; ++k) \
        acc[ai][bj][m][n] = __builtin_amdgcn_mfma_f32_16x16x32_bf16(Bt[n][k], At[m][k], acc[ai][bj][m][n], 0, 0, 0); __builtin_amdgcn_s_setprio(0); } while (0)
#define PG8_WAIT_V(n) asm volatile("s_waitcnt vmcnt(" #n ")" ::: "memory")
#define PG8_WAIT_L(n) asm volatile("s_waitcnt lgkmcnt(" #n ")" ::: "memory")
#define PG8_BAR __builtin_amdgcn_s_barrier()
#define PG8_SCHED __builtin_amdgcn_sched_barrier(0)
    Unit cur, nxt; int ui = 0;
    if (!S.next(0, cur)) return;
    f32x4 acc[2][2][4][2];
#pragma unroll
    for (int a = 0; a < 2; ++a)
#pragma unroll
        for (int b = 0; b < 2; ++b)
#pragma unroll
            for (int m = 0; m < 4; ++m)
#pragma unroll
                for (int n = 0; n < 2; ++n) acc[a][b][m][n] = (f32x4){0.f, 0.f, 0.f, 0.f};
    bf16x8 At[4][2], B0[2][2], B1[2][2];
    const char* cA = (const char*)g.A + cur.aoff; const char* cB = (const char*)g.Bt + cur.boff;
    S.a_ready(cur);
    if constexpr (SP2) {
        PG8_STAGE(PG8_SB(0, 0), cB, voffB); PG8_STAGE(PG8_SB(0, 1), cB + hstepB, voffB); PG8_STAGE(PG8_SA(0, 0), cA, voffA); PG8_STAGE(PG8_SA(0, 1), cA + hstepA, voffA);
        if (wr == 1) PG8_BAR;
        PG8_WAIT_V(2); PG8_BAR;
        PG8_STAGE(PG8_SB(1, 0), cB + kstep, voffB); PG8_STAGE(PG8_SA(1, 0), cA + kstep, voffA); PG8_STAGE(PG8_SB(1, 1), cB + hstepB + kstep, voffB);
        PG8_WAIT_V(6); PG8_BAR;
    } else {
        PG8_STAGE(PG8_SB(0, 0), cB, voffB); PG8_STAGE(PG8_SA(0, 0), cA, voffA); PG8_STAGE(PG8_SB(0, 1), cB + hstepB, voffB); PG8_STAGE(PG8_SA(0, 1), cA + hstepA, voffA);
        if (wr == 1) PG8_BAR;
        PG8_WAIT_V(4); PG8_BAR;
        PG8_STAGE(PG8_SB(1, 0), cB + kstep, voffB); PG8_STAGE(PG8_SA(1, 0), cA + kstep, voffA); PG8_STAGE(PG8_SB(1, 1), cB + hstepB + kstep, voffB);
        PG8_WAIT_V(6); PG8_BAR;
    }
    for (;;) {
        const bool has_next = S.next(ui + 1, nxt);
        const char* nA = has_next ? (const char*)g.A + nxt.aoff : cA; const char* nB = has_next ? (const char*)g.Bt + nxt.boff : cB;
        for (int t = 0; t < nt; t += 2) {
            const bool last = (t == nt - 2);
            const char* a1 = cA + (size_t)(t + 1) * kstep;
            const char* a2 = last ? nA : cA + (size_t)(t + 2) * kstep; const char* b2 = last ? nB : cB + (size_t)(t + 2) * kstep;
            const char* a3 = a2 + kstep; const char* b3 = b2 + kstep;
            if (last && has_next) S.a_ready(nxt);
            if constexpr (SP2) {
            PG8_LDB(B0, 0, 0); PG8_LDB(B1, 0, 1); PG8_SCHED; PG8_LDA(At, 0, 0); PG8_STAGE(PG8_SA(1, 1), a1 + hstepA, voffA);
            PG8_WAIT_V(8); PG8_WAIT_L(0); PG8_BAR; PG8_MMA(0, 0, At, B0); PG8_MMA(0, 1, At, B1); PG8_BAR; PG8_SCHED;
            PG8_LDA(At, 0, 1); PG8_STAGE(PG8_SB(0, 0), b2, voffB); PG8_STAGE(PG8_SB(0, 1), b2 + hstepB, voffB); PG8_STAGE(PG8_SA(0, 0), a2, voffA);
            PG8_WAIT_V(8); PG8_WAIT_L(0); PG8_BAR; PG8_MMA(1, 0, At, B0); PG8_MMA(1, 1, At, B1); PG8_BAR; PG8_SCHED;
            PG8_LDB(B0, 1, 0); PG8_LDB(B1, 1, 1); PG8_SCHED; PG8_LDA(At, 1, 0); PG8_STAGE(PG8_SA(0, 1), a2 + hstepA, voffA);
            PG8_WAIT_V(8); PG8_WAIT_L(0); PG8_BAR; PG8_MMA(0, 0, At, B0); PG8_MMA(0, 1, At, B1); PG8_BAR; PG8_SCHED;
            PG8_LDA(At, 1, 1); PG8_STAGE(PG8_SB(1, 0), b3, voffB); PG8_STAGE(PG8_SB(1, 1), b3 + hstepB, voffB); PG8_STAGE(PG8_SA(1, 0), a3, voffA);
            PG8_WAIT_V(8); PG8_WAIT_L(0); PG8_BAR; PG8_MMA(1, 0, At, B0); PG8_MMA(1, 1, At, B1); PG8_BAR; PG8_SCHED;
            } else {
            PG8_LDB(B0, 0, 0); PG8_SCHED; PG8_LDA(At, 0, 0); PG8_STAGE(PG8_SA(1, 1), a1 + hstepA, voffA);
            PG8_WAIT_L(8); PG8_BAR; PG8_WAIT_L(0); PG8_MMA(0, 0, At, B0); PG8_BAR; PG8_SCHED;
            PG8_LDB(B1, 0, 1); PG8_STAGE(PG8_SB(0, 0), b2, voffB);
            PG8_BAR; PG8_WAIT_L(0); PG8_MMA(0, 1, At, B1); PG8_BAR;
            PG8_LDA(At, 0, 1); PG8_STAGE(PG8_SA(0, 0), a2, voffA);
            PG8_BAR; PG8_WAIT_L(0); PG8_MMA(1, 0, At, B0); PG8_BAR; PG8_SCHED;
            PG8_STAGE(PG8_SB(0, 1), b2 + hstepB, voffB);
            PG8_WAIT_V(6); PG8_BAR; PG8_MMA(1, 1, At, B1); PG8_BAR;
            PG8_LDB(B0, 1, 0); PG8_SCHED; PG8_LDA(At, 1, 0); PG8_STAGE(PG8_SA(0, 1), a2 + hstepA, voffA);
            PG8_WAIT_L(8); PG8_BAR; PG8_WAIT_L(0); PG8_MMA(0, 0, At, B0); PG8_BAR; PG8_SCHED;
            PG8_LDB(B1, 1, 1); PG8_STAGE(PG8_SB(1, 0), b3, voffB);
            PG8_BAR; PG8_WAIT_L(0); PG8_MMA(0, 1, At, B1); PG8_BAR;
            PG8_LDA(At, 1, 1); PG8_STAGE(PG8_SA(1, 0), a3, voffA);
            PG8_BAR; PG8_WAIT_L(0); PG8_MMA(1, 0, At, B0); PG8_BAR; PG8_SCHED;
            PG8_STAGE(PG8_SB(1, 1), b3 + hstepB, voffB);
            PG8_WAIT_V(6); PG8_BAR; PG8_MMA(1, 1, At, B1); PG8_BAR;
            }
        }
        if constexpr (ALIGN_EPI) { if (wr == 0) PG8_BAR; }
        if constexpr (!Epi::AFTER_DRAIN) { E(acc, cur, wr, wc, fr, fq); S.done(cur); }
        if (!has_next) break;
#pragma unroll
        for (int a = 0; a < 2; ++a)
#pragma unroll
            for (int b = 0; b < 2; ++b)
#pragma unroll
                for (int m = 0; m < 4; ++m)
#pragma unroll
                    for (int n = 0; n < 2; ++n) acc[a][b][m][n] = (f32x4){0.f, 0.f, 0.f, 0.f};
        cur = nxt; cA = nA; cB = nB; ++ui;
        if constexpr (ALIGN_EPI) { if (wr == 1) PG8_BAR; }
    }
    PG8_WAIT_V(0);
    if constexpr (!ALIGN_EPI) { if (wr == 0) PG8_BAR; }
    PG8_BAR;
    if constexpr (Epi::AFTER_DRAIN) { E.fused(acc, cur, wr, wc, fr, fq, lds, wid, lane); S.done(cur); }
#undef PG8_SA
#undef PG8_SB
#undef PG8_STAGE
#undef PG8_LDA
#undef PG8_LDB
#undef PG8_MMA
#undef PG8_WAIT_V
#undef PG8_WAIT_L
#undef PG8_BAR
#undef PG8_SCHED
}
}


#include <hip/hip_bf16.h>
#include <cmath>
namespace attn_body {
using bf16=__hip_bfloat16;
using bf16x8=__attribute__((ext_vector_type(8)))short;
using s16x4=__attribute__((ext_vector_type(4)))short;
using f32x16=__attribute__((ext_vector_type(16)))float;
using u32x4=__attribute__((ext_vector_type(4)))unsigned;
constexpr int BATCH=4,NHEAD=8,SEQ=4096,D=64,DM=NHEAD*D,DMO=1024;
constexpr int NW=8,QBLK=32,QB=QBLK*NW,KVBLK=64,NQB=SEQ/QB;
constexpr int ATTN_PITCH=DM, ATTN_UNIT_ROWS=QB;
typedef __attribute__((address_space(3))) float* lds_fptr; typedef float f32x4a __attribute__((ext_vector_type(4)));
__device__ __forceinline__ int crow(int r,int hi){return (r&3)+8*(r>>2)+4*hi;}
#define SBAR() __builtin_amdgcn_sched_barrier(0)
__device__ __forceinline__ void cmask(f32x16&p0,f32x16&p1,int jb,int qrel,int hi){
  const float NEG=-INFINITY; int kb=64*jb+4*hi;
  #pragma unroll
  for(int r=0;r<16;++r){int kv=kb+(r&3)+8*(r>>2); if(kv>qrel)p0[r]=NEG; if(kv+32>qrel)p1[r]=NEG;}
}

constexpr int NSLOT=3, SLOTB=8192;
constexpr int LDS_K=0, LDS_V=NSLOT*SLOTB, LDS_WS=2*NSLOT*SLOTB, LDS_OST=LDS_WS+NW*64*4, LDS_F=LDS_OST+NW*4096, LDS_BYTES=LDS_F+SEQ*4;
constexpr float C2=0.125f*1.4426950408889634f;
__device__ __forceinline__ void glds16(const void*gsrc,unsigned lds_dst){unsigned keep;
  asm volatile("s_mov_b32 %0, m0\n\ts_mov_b32 m0, %2\n\ts_nop 0\n\tglobal_load_lds_dwordx4 %1, off\n\ts_mov_b32 m0, %0":"=&s"(keep):"v"(gsrc),"s"(lds_dst):"memory");}
__device__ __forceinline__ float max3f(float a,float b,float c){float r;asm("v_max3_f32 %0, %1, %2, %3":"=v"(r):"v"(a),"v"(b),"v"(c));return r;}
__device__ __forceinline__ float max2f(float a,float b){float r;asm("v_max_f32_e32 %0, %1, %2":"=v"(r):"v"(a),"v"(b));return r;}
__device__ __forceinline__ float fadd_s(float a,float b){float r;asm("v_add_f32_e32 %0, %1, %2":"=v"(r):"v"(a),"v"(b));return r;}
__device__ __forceinline__ float fsub_s(float a,float b){float r;asm("v_sub_f32_e32 %0, %1, %2":"=v"(r):"v"(a),"v"(b));return r;}
typedef float f32x2_t __attribute__((ext_vector_type(2))); typedef __bf16 bf16x2_t __attribute__((ext_vector_type(2)));
__device__ __forceinline__ unsigned cvtpk_s(float lo,float hi){f32x2_t v={lo,hi};bf16x2_t b=__builtin_convertvector(v,bf16x2_t);return __builtin_bit_cast(unsigned,b);}
#define WAIT_BAR(N) asm volatile("s_waitcnt vmcnt(" #N ") lgkmcnt(0)\n\ts_barrier":::"memory")

__device__ __forceinline__ void qkt(f32x16&p0,f32x16&p1,const char*Kslot,const bf16x8*qr,const f32x16&negm,int r32,int hi){
  const char*kb=Kslot+hi*1024+r32*16;
  #pragma unroll
  for(int d0=0;d0<4;++d0){
    const bf16x8 b0=*reinterpret_cast<const bf16x8*>(kb+d0*2048);
    const bf16x8 b1=*reinterpret_cast<const bf16x8*>(kb+d0*2048+512);
    if(d0==0){p0=__builtin_amdgcn_mfma_f32_32x32x16_bf16(b0,qr[0],negm,0,0,0);p1=__builtin_amdgcn_mfma_f32_32x32x16_bf16(b1,qr[0],negm,0,0,0);}
    else{p0=__builtin_amdgcn_mfma_f32_32x32x16_bf16(b0,qr[d0],p0,0,0,0);p1=__builtin_amdgcn_mfma_f32_32x32x16_bf16(b1,qr[d0],p1,0,0,0);}}
}
typedef __attribute__((address_space(3))) const char* lds_cptr;
typedef short v4i16_t __attribute__((ext_vector_type(4)));
__device__ __forceinline__ void kload8(bf16x8*kf,lds_cptr kp){
  kf[0]=*(const __attribute__((address_space(3))) bf16x8*)(kp);      kf[1]=*(const __attribute__((address_space(3))) bf16x8*)(kp+512);
  kf[2]=*(const __attribute__((address_space(3))) bf16x8*)(kp+2048); kf[3]=*(const __attribute__((address_space(3))) bf16x8*)(kp+2560);
  kf[4]=*(const __attribute__((address_space(3))) bf16x8*)(kp+4096); kf[5]=*(const __attribute__((address_space(3))) bf16x8*)(kp+4608);
  kf[6]=*(const __attribute__((address_space(3))) bf16x8*)(kp+6144); kf[7]=*(const __attribute__((address_space(3))) bf16x8*)(kp+6656);
}
__device__ __forceinline__ void kload2(bf16x8*kf,lds_cptr kp,int j){ kf[2*j]=*(const __attribute__((address_space(3))) bf16x8*)(kp+j*2048); kf[2*j+1]=*(const __attribute__((address_space(3))) bf16x8*)(kp+j*2048+512); }
__device__ __forceinline__ s16x4 vtr(lds_cptr p){ return __builtin_bit_cast(s16x4,__builtin_amdgcn_ds_read_tr16_b64_v4i16((__attribute__((address_space(3))) v4i16_t*)p)); }
__device__ __forceinline__ float rowmax(const f32x16&p0,const f32x16&p1){
  float a=max3f(p0[0],p0[1],p1[0]),b=max3f(p0[2],p0[3],p1[1]);a=max3f(a,p1[2],p1[3]);
  #pragma unroll
  for(int r=4;r<16;r+=4){a=max3f(a,p0[r],p0[r+1]);b=max3f(b,p0[r+2],p0[r+3]);a=max3f(a,p1[r],p1[r+1]);b=max3f(b,p1[r+2],p1[r+3]);}
  const float m=max2f(a,b);
  auto rr=__builtin_amdgcn_permlane32_swap(__float_as_uint(m),__float_as_uint(m),false,false);
  return max2f(__uint_as_float(rr[0]),__uint_as_float(rr[1]));
}
__device__ __forceinline__ void pv(f32x16*o,int vb,bf16x8 pa0,bf16x8 pa1,bf16x8 pa2,bf16x8 pa3){
  #pragma unroll
  for(int d0=0;d0<2;++d0){s16x4 lo[4],hi[4];
    #pragma unroll
    for(int ks=0;ks<4;++ks){
      asm volatile("ds_read_b64_tr_b16 %0,%1 offset:%c2":"=&v"(lo[ks]):"v"(vb),"i"(d0*4096+ks*1024):"memory");
      asm volatile("ds_read_b64_tr_b16 %0,%1 offset:%c2":"=&v"(hi[ks]):"v"(vb),"i"(d0*4096+ks*1024+512):"memory");}
    asm volatile("s_waitcnt lgkmcnt(0)":::"memory");SBAR();
    #define PK(k) (bf16x8){lo[k][0],lo[k][1],lo[k][2],lo[k][3],hi[k][0],hi[k][1],hi[k][2],hi[k][3]}
    o[d0]=__builtin_amdgcn_mfma_f32_32x32x16_bf16(pa0,PK(0),o[d0],0,0,0);
    o[d0]=__builtin_amdgcn_mfma_f32_32x32x16_bf16(pa1,PK(1),o[d0],0,0,0);
    o[d0]=__builtin_amdgcn_mfma_f32_32x32x16_bf16(pa2,PK(2),o[d0],0,0,0);
    o[d0]=__builtin_amdgcn_mfma_f32_32x32x16_bf16(pa3,PK(3),o[d0],0,0,0);
    #undef PK
  }
}

#ifndef ATTN_STORE16
#define ATTN_STORE16(p,v) (*(u32x4*)(p)=(v))
#endif
template<int THRL> __device__ __forceinline__ void attn_unit(int b,int h,int qb,const bf16*Q,const bf16*__restrict__ K,const bf16*__restrict__ V,bf16*O,const float*__restrict__ Fg,char*shm){
  int tid_=threadIdx.x; asm volatile("":"+v"(tid_)); const int tid=tid_,lane=tid&63,r32=lane&31,hi=lane>>5; const int wid=__builtin_amdgcn_readfirstlane(tid>>6);
  const long rowbase=(long)b*SEQ; const int q0=qb*QB;
  const lds_fptr Fl3=(lds_fptr)(shm+LDS_F);
  { const float*Fs=Fg+(long)(b*NHEAD+h)*SEQ; for(int i=tid;i<q0+QB;i+=NW*64)Fl3[i]=Fs[i]; }
  const bf16*Qw=Q+(rowbase+q0+wid*QBLK)*DM+h*D;
  const bf16*Kh=K+rowbase*DM+h*D,*Vh=V+rowbase*DM+h*D;
  const unsigned lds0=(unsigned)(uintptr_t)shm;
  float*wsf=(float*)(shm+LDS_WS)+wid*64;
  const bf16*ksrc=Kh+(long)lane*DM+wid*8;
  const bf16*vsrc=Vh+(long)(16*(wid&3)+(lane>>2))*DM+(wid>>2)*32+(lane&3)*8;
  const unsigned kdst=lds0+LDS_K+wid*1024, vdst=lds0+LDS_V+wid*1024;
  #define DMA_K(t,slot) glds16(ksrc+(long)(t)*KVBLK*DM,(unsigned)__builtin_amdgcn_readfirstlane(kdst+(slot)))
  #define DMA_V(t,slot) glds16(vsrc+(long)(t)*KVBLK*DM,(unsigned)__builtin_amdgcn_readfirstlane(vdst+(slot)))
  const int vb0=(int)(lds0+LDS_V)+((lane>>4)&1)*32+(lane&3)*8+(4*hi+((lane&15)>>2))*64;
  const char*Kbase=shm+LDS_K; bf16x8 kf[8];
  const lds_cptr shm3=(lds_cptr)shm; const lds_cptr kp0=shm3+LDS_K+hi*1024+r32*16; const lds_cptr vp0=shm3+LDS_V+((lane>>4)&1)*32+(lane&3)*8+(4*hi+((lane&15)>>2))*64;
  const int NT=(q0+QB)/KVBLK;
  DMA_K(0,0);DMA_V(0,0);DMA_K(1,SLOTB);
  bf16x8 qr[4];
  #pragma unroll
  for(int d0=0;d0<4;++d0)qr[d0]=*reinterpret_cast<const bf16x8*>(&Qw[(long)r32*DM+d0*16+hi*8]);
  float mhat=0.f,l_reg=0.f,fqv=0.f;f32x16 o[2];o[0]=f32x16{};o[1]=f32x16{};float nm=0.f;
  const int qrel=wid*QBLK+r32;
  #define CMASK(P0,P1,t) do{int jb_=(t)-(NT-4); if(jb_>=0)cmask(P0,P1,jb_,qrel,hi);}while(0)
  bool resc=false;
  #define START(P0,P1) do{ const float rm=rowmax(P0,P1); resc=false; \
    { const float dl=rm; mhat=fadd_s(mhat,dl); \
      _Pragma("unroll") for(int r=0;r<16;++r){P0[r]=fsub_s(P0[r],dl);P1[r]=fsub_s(P1[r],dl);} \
      nm=fqv-mhat; } \
    _Pragma("unroll") for(int r=0;r<16;++r)P0[r]=__builtin_amdgcn_exp2f(P0[r]); }while(0)
  #define RESC() do{ if(resc){ asm volatile("s_waitcnt lgkmcnt(0)":::"memory"); \
      _Pragma("unroll") for(int d_=0;d_<2;++d_) _Pragma("unroll") for(int r=0;r<16;++r)o[d_][r]*=wsf[crow(r,hi)]; } }while(0)
  f32x16 pA0,pA1,pB0,pB1;
  int sl_prev=0,sl_cur=0,sl_next=SLOTB;
  #define ROT() do{sl_prev=sl_cur;sl_cur=sl_next;sl_next=(sl_next==(NSLOT-1)*SLOTB)?0:sl_next+SLOTB;}while(0)
  DMA_K(2,2*SLOTB);
  WAIT_BAR(3);
  fqv=Fl3[q0+qrel];
  nm=fqv;
  #define FSUB(C0,C1,t) do{ const __attribute__((address_space(3))) f32x4a*fp_=(const __attribute__((address_space(3))) f32x4a*)(Fl3+(t)*64+4*hi); \
    _Pragma("unroll") for(int j_=0;j_<4;++j_){ const f32x4a a_=fp_[2*j_],b_=fp_[8+2*j_]; \
      C0[4*j_]+=nm-a_[0];C0[4*j_+1]+=nm-a_[1];C0[4*j_+2]+=nm-a_[2];C0[4*j_+3]+=nm-a_[3]; \
      C1[4*j_]+=nm-b_[0];C1[4*j_+1]+=nm-b_[1];C1[4*j_+2]+=nm-b_[2];C1[4*j_+3]+=nm-b_[3]; } }while(0)
  qkt(pA0,pA1,Kbase,qr,f32x16{},r32,hi);asm volatile("s_nop 15\n\ts_nop 7":"+v"(pA0),"+v"(pA1));FSUB(pA0,pA1,0);CMASK(pA0,pA1,0);
  START(pA0,pA1);
  _Pragma("unroll") for(int r=0;r<16;++r)pA1[r]=__builtin_amdgcn_exp2f(pA1[r]);
  WAIT_BAR(0);
  DMA_K(3,0);DMA_V(1,SLOTB);
  ROT();
  kload8(kf,kp0+sl_cur);
  WAIT_BAR(2);
  s16x4 vlo[8],vhi[8]; u32x4 pw0,pw1,pw2,pw3;
  #define PKW(P,B) cvtpk_s(P[B],P[B+1])
  #define PAF(k) __builtin_bit_cast(bf16x8,pw##k)
  #define VFR(i) (bf16x8){vlo[i][0],vlo[i][1],vlo[i][2],vlo[i][3],vhi[i][0],vhi[i][1],vhi[i][2],vhi[i][3]}
  #define PIN(x) asm volatile("":"+v"(x))
  #define MX3(a,b,c) __builtin_fmaxf(__builtin_fmaxf((a),(b)),(c))
  #define GAPA(MF,A0,A1,A2,A3,W0,W1,PW) do{ MF; sacc+=A0; sacc+=A1; sacc+=A2; sacc+=A3; PIN(sacc); W0; W1; PIN(PW); SBAR(); }while(0)
  #define EX(v) __builtin_amdgcn_exp2f(v)
  #define GAPB(MF,X,B) do{ MF; X[B]=EX(X[B]); X[B+1]=EX(X[B+1]); X[B+2]=EX(X[B+2]); X[B+3]=EX(X[B+3]); PIN(X); SBAR(); }while(0)
  #define VRD(i) do{ vlo[i]=vtr(vp_+(((i)>>2)*4096+((i)&3)*1024)); vhi[i]=vtr(vp_+(((i)>>2)*4096+((i)&3)*1024+512)); }while(0)
  #define KRD(G,j) do{ if(G){ kload2(kf,kp0+sl_next,j); SBAR(); } }while(0)
  #define STEP(C0,C1,P0,P1,t,GK,GV,GL) do{ SBAR(); \
    const lds_cptr vp_=vp0+sl_prev; \
    VRD(0); SBAR(); float sacc=(P0[0]+P0[1]); \
    GAPA(C0=__builtin_amdgcn_mfma_f32_32x32x16_bf16(kf[0],qr[0],f32x16{},0,0,0), P0[2],P0[3],P0[4],P0[5],     pw0[0]=PKW(P0,0), pw0[1]=PKW(P0,2), pw0); \
    VRD(4); SBAR(); GAPA(C1=__builtin_amdgcn_mfma_f32_32x32x16_bf16(kf[1],qr[0],f32x16{},0,0,0), P0[6],P0[7],P0[8],P0[9],     pw0[2]=PKW(P0,4), pw0[3]=PKW(P0,6), pw0); \
    VRD(1); SBAR(); GAPA(C0=__builtin_amdgcn_mfma_f32_32x32x16_bf16(kf[2],qr[1],C0,0,0,0),   P0[10],P0[11],P0[12],P0[13], pw1[0]=PKW(P0,8), pw1[1]=PKW(P0,10), pw1); \
    VRD(5); SBAR(); GAPA(C1=__builtin_amdgcn_mfma_f32_32x32x16_bf16(kf[3],qr[1],C1,0,0,0),   P0[14],P0[15],P1[0],P1[1],   pw1[2]=PKW(P0,12),pw1[3]=PKW(P0,14), pw1); \
    VRD(2); SBAR(); GAPA(C0=__builtin_amdgcn_mfma_f32_32x32x16_bf16(kf[4],qr[2],C0,0,0,0),   P1[2],P1[3],P1[4],P1[5],     pw2[0]=PKW(P1,0), pw2[1]=PKW(P1,2), pw2); \
    VRD(6); SBAR(); GAPA(C1=__builtin_amdgcn_mfma_f32_32x32x16_bf16(kf[5],qr[2],C1,0,0,0),   P1[6],P1[7],P1[8],P1[9],     pw2[2]=PKW(P1,4), pw2[3]=PKW(P1,6), pw2); \
    VRD(3); SBAR(); GAPA(C0=__builtin_amdgcn_mfma_f32_32x32x16_bf16(kf[6],qr[3],C0,0,0,0),   P1[10],P1[11],P1[12],P1[13], pw3[0]=PKW(P1,8), pw3[1]=PKW(P1,10), pw3); \
    VRD(7); SBAR(); GAPA(C1=__builtin_amdgcn_mfma_f32_32x32x16_bf16(kf[7],qr[3],C1,0,0,0),   P1[14],P1[15],0.f,0.f,       pw3[2]=PKW(P1,12),pw3[3]=PKW(P1,14), pw3); \
    l_reg+=sacc; \
    if(GK){DMA_K((t)+3,sl_cur);} if(GV){DMA_V((t)+1,sl_next);} \
    FSUB(C0,C1,t); \
    CMASK(C0,C1,t); \
    { float a=MX3(C0[0],C0[1],C1[0]),b=MX3(C0[2],C0[3],C1[1]); a=MX3(a,C1[2],C1[3]); \
      _Pragma("unroll") for(int r=4;r<16;r+=4){a=MX3(a,C0[r],C0[r+1]);b=MX3(b,C0[r+2],C0[r+3]);a=MX3(a,C1[r],C1[r+1]);b=MX3(b,C1[r+2],C1[r+3]);} \
      float rm=__builtin_fmaxf(a,b); { auto rr=__builtin_amdgcn_permlane32_swap(__float_as_uint(rm),__float_as_uint(rm),false,false); rm=__builtin_fmaxf(__uint_as_float(rr[0]),__uint_as_float(rr[1])); } \
      resc=false; \
      if(__builtin_expect(__any(rm>(float)THRL),0)){ const float dl=__builtin_fmaxf(rm,0.f); mhat+=dl; \
        _Pragma("unroll") for(int r=0;r<16;++r){C0[r]-=dl;C1[r]-=dl;} \
        nm=fqv-mhat; \
        const float f=__builtin_amdgcn_exp2f(-dl); l_reg*=f; if(hi==0)wsf[r32]=f; resc=true; } } \
    SBAR(); \
    GAPB(o[0]=__builtin_amdgcn_mfma_f32_32x32x16_bf16(PAF(0),VFR(0),o[0],0,0,0), C0,0); \
    GAPB(o[1]=__builtin_amdgcn_mfma_f32_32x32x16_bf16(PAF(0),VFR(4),o[1],0,0,0), C0,4); \
    KRD(GL,0); GAPB(o[0]=__builtin_amdgcn_mfma_f32_32x32x16_bf16(PAF(1),VFR(1),o[0],0,0,0), C0,8); \
    KRD(GL,1); GAPB(o[1]=__builtin_amdgcn_mfma_f32_32x32x16_bf16(PAF(1),VFR(5),o[1],0,0,0), C0,12); \
    KRD(GL,2); GAPB(o[0]=__builtin_amdgcn_mfma_f32_32x32x16_bf16(PAF(2),VFR(2),o[0],0,0,0), C1,0); \
    KRD(GL,3); GAPB(o[1]=__builtin_amdgcn_mfma_f32_32x32x16_bf16(PAF(2),VFR(6),o[1],0,0,0), C1,4); \
    GAPB(o[0]=__builtin_amdgcn_mfma_f32_32x32x16_bf16(PAF(3),VFR(3),o[0],0,0,0), C1,8); \
    GAPB(o[1]=__builtin_amdgcn_mfma_f32_32x32x16_bf16(PAF(3),VFR(7),o[1],0,0,0), C1,12); \
    }while(0)
  int t=1;
  #undef CMASK
  #define CMASK(P0,P1,t) do{}while(0)
  for(;t+5<NT;t+=2){
    STEP(pB0,pB1,pA0,pA1,t,true,true,true);     WAIT_BAR(2); RESC(); ROT();
    STEP(pA0,pA1,pB0,pB1,t+1,true,true,true);   WAIT_BAR(2); RESC(); ROT();
  }
  #undef CMASK
  #define CMASK(P0,P1,t) do{int jb_=(t)-(NT-4); if(jb_>=0)cmask(P0,P1,jb_,qrel,hi);}while(0)
  #define ENDW(tt) do{ if((tt)+3<NT){WAIT_BAR(2);} else if((tt)+2<NT){WAIT_BAR(1);} else {WAIT_BAR(0);} }while(0)
  for(;t+1<NT;t+=2){
    STEP(pB0,pB1,pA0,pA1,t,(t+3<NT),(t+1<NT),(t+1<NT));       ENDW(t);   RESC(); ROT();
    STEP(pA0,pA1,pB0,pB1,t+1,(t+4<NT),(t+2<NT),(t+2<NT));     ENDW(t+1); RESC(); ROT();
  }
  STEP(pB0,pB1,pA0,pA1,NT-1,false,false,false); RESC();
  { float sacc=pB0[0]+pB0[1]; _Pragma("unroll") for(int r=2;r<16;++r)sacc+=pB0[r]; _Pragma("unroll") for(int r=0;r<16;++r)sacc+=pB1[r]; l_reg+=sacc;
    pw0=(u32x4){PKW(pB0,0),PKW(pB0,2),PKW(pB0,4),PKW(pB0,6)};pw1=(u32x4){PKW(pB0,8),PKW(pB0,10),PKW(pB0,12),PKW(pB0,14)};pw2=(u32x4){PKW(pB1,0),PKW(pB1,2),PKW(pB1,4),PKW(pB1,6)};pw3=(u32x4){PKW(pB1,8),PKW(pB1,10),PKW(pB1,12),PKW(pB1,14)};
    SBAR(); pv(o,vb0+sl_cur,PAF(0),PAF(1),PAF(2),PAF(3)); }
  #undef PKW
  #undef PAF
  #undef VFR
  #undef PIN
  #undef MX3
  #undef GAPA
  #undef GAPB
  #undef EX
  #undef VRD
  #undef KRD
  #undef STEP
  #undef ENDW
  {auto rr=__builtin_amdgcn_permlane32_swap(__float_as_uint(l_reg),__float_as_uint(l_reg),false,false);l_reg=__uint_as_float(rr[0])+__uint_as_float(rr[1]);}
  if(hi==0)wsf[32+r32]=l_reg;asm volatile("s_waitcnt lgkmcnt(0)":::"memory");
  float rli[16];
  #pragma unroll
  for(int r=0;r<16;++r)rli[r]=__builtin_amdgcn_rcpf(wsf[32+crow(r,hi)]);
  bf16*Ow=O+(rowbase+q0+wid*QBLK)*DMO+h*D;
  { bf16*stg=(bf16*)(shm+LDS_OST)+wid*2048;
    #pragma unroll
    for(int r=0;r<16;++r){const int orow=crow(r,hi);
      #pragma unroll
      for(int d0=0;d0<2;++d0)stg[orow*64+d0*32+r32]=__float2bfloat16(o[d0][r]*rli[r]);}
    asm volatile("s_waitcnt lgkmcnt(0)":::"memory");
    #pragma unroll
    for(int i=0;i<4;++i){const int row=i*8+(lane>>3),ch=lane&7; const u32x4 v=*(const u32x4*)(stg+row*64+ch*8); ATTN_STORE16(Ow+(long)row*DMO+ch*8,v);} }
  asm volatile("s_waitcnt lgkmcnt(0)\n\ts_barrier":::"memory");
  #undef DMA_K
  #undef DMA_V
  #undef CMASK
  #undef START
  #undef RESC
  #undef ROT
  #undef FSUB
}
constexpr int ATTN_LDS_BYTES=LDS_BYTES;
struct AttnTensors { const bf16* Q; const bf16* K; const bf16* V; bf16* O; const float* F; };
struct AttnUnit { int bh; int qb; };
struct StaticOrder {
  int vcu;
  __device__ __forceinline__ explicit StaticOrder(int grid,int block):vcu((block%8)*(grid/8)+block/8){}
  __device__ __forceinline__ bool next(int i,AttnUnit&u)const{ if(i>=2)return false; const int s=vcu&7; u.bh=vcu>>3; u.qb=(i==0)?15-s:s; return true; }
  __device__ __forceinline__ void a_ready(const AttnUnit&)const{}
  __device__ __forceinline__ void done(const AttnUnit&)const{}
};
template<class Sched,int THRL=8> __device__ __forceinline__ void attn_phase(char*lds,const AttnTensors&T,const Sched&S){
  AttnUnit u;
  for(int i=0;S.next(i,u);++i){ S.a_ready(u); attn_unit<THRL>(u.bh/NHEAD,u.bh%NHEAD,u.qb,T.Q,T.K,T.V,T.O,T.F,lds); S.done(u); }
}
#undef SBAR
#undef WAIT_BAR
}

constexpr int NWAVES = 8;
constexpr int M = 16384, D = 1024, SEQ = 4096, NBATCH = 4, FF = 4096;
constexpr float EPS = 1e-6f;
constexpr size_t MiB = 1u << 20;
constexpr size_t WS_CTL = 0, CTL_ZERO_BYTES = 65536;
constexpr size_t WS_WINE = 1 * MiB, WS_WOUTE = 5 * MiB, WS_WGLU = 7 * MiB, WS_POOLB = 7 * MiB + 512 * 1024, WS_WSA = 7 * MiB + 768 * 1024;
constexpr size_t WS_WINO = 8 * MiB, WS_WOUTO = 11 * MiB, WS_W1 = 13 * MiB, WS_W2 = 29 * MiB, WS_S5W1 = 45 * MiB, WS_TOEP = 49 * MiB;
constexpr size_t WS_F = 55 * MiB, WS_FL = 55 * MiB + 512 * 1024;
constexpr size_t WS_XN = 56 * MiB, WS_Y = 88 * MiB, WS_S = 88 * MiB, WS_GY = 104 * MiB;
constexpr size_t WS_H = 120 * MiB, WS_U = 120 * MiB, WS_Q = 144 * MiB, WS_MIX = 192 * MiB;
constexpr size_t WS_XC = 120 * MiB, WS_POOLED = 168 * MiB, WS_ASGU = 224 * MiB, WS_END = 248 * MiB;
constexpr int CW_BAR = 4096;
constexpr int RING_OFF = 0, RING_BYTES = 131072, LDSCTL_OFF = RING_BYTES, MISC_OFF = LDSCTL_OFF + 320, LDS_BYTES = 147456;

#define GAS __attribute__((address_space(1)))
#define LAS __attribute__((address_space(3)))
typedef unsigned short bf16;
typedef unsigned v4u __attribute__((ext_vector_type(4)));
typedef float f32x4 __attribute__((ext_vector_type(4)));
typedef short bf16x8 __attribute__((ext_vector_type(8)));
typedef GAS unsigned gu32;
typedef GAS unsigned long long gu64;
#define RLX_AGENT __ATOMIC_RELAXED, __HIP_MEMORY_SCOPE_AGENT
#define LDS_WAIT() asm volatile("s_waitcnt lgkmcnt(0)" ::: "memory")
#define VM_WAIT() asm volatile("s_waitcnt vmcnt(0)" ::: "memory")
__device__ __forceinline__ unsigned long long rt() { return __builtin_amdgcn_s_memrealtime(); }
__device__ __forceinline__ unsigned f2bf(float f) { unsigned u = __builtin_bit_cast(unsigned, f); return (u + 0x7fffu + ((u >> 16) & 1u)) >> 16; }
__device__ __forceinline__ unsigned pk2(float lo, float hi) { return f2bf(lo) | (f2bf(hi) << 16); }
#define XB_TMO      128
#define XB_XCNT(j)  (256  + 64 * (j))
#define XB_XSUB(j)  (1280 + 64 * (j))
#define XB_XGEN(j)  (2304 + 64 * (j))
#define XB_TOP      3328
#define XB_TOPGEN   3392
#define XCD_BAR_WORDS 3456
#define XB_SPIN_CAP (1u << 18)

__device__ __forceinline__ unsigned xb_ld(unsigned* p)              { return __hip_atomic_load(p, __ATOMIC_RELAXED, __HIP_MEMORY_SCOPE_AGENT); }
__device__ __forceinline__ unsigned xb_add(unsigned* p, unsigned v) { return __hip_atomic_fetch_add(p, v, __ATOMIC_RELAXED, __HIP_MEMORY_SCOPE_AGENT); }
__device__ __forceinline__ unsigned xb_xcc_id() { return (unsigned)__builtin_amdgcn_s_getreg((3 << 11) | 20) & 0xFu; }
#define XB_SPIN(cond, bar) do { unsigned _sp = 0; while (cond) { __builtin_amdgcn_s_sleep(1); \
    if ((++_sp & 255u) == 0u) { if (xb_ld(&(bar)[XB_TMO])) break; if (_sp > XB_SPIN_CAP) { atomicAdd(&(bar)[XB_TMO], 1u); break; } } } } while (0)

struct XcdBarrier {
    unsigned* bar; unsigned x;
    volatile LAS unsigned* st;
};

__device__ __forceinline__ XcdBarrier xcd_barrier_post(unsigned* bar, volatile LAS unsigned* st) {
    XcdBarrier b; b.bar = bar; b.x = xb_xcc_id(); b.st = st;
    if (threadIdx.x == 0) (void)xb_add(&bar[XB_XCNT(b.x)], 1u);
    return b;
}
__device__ __forceinline__ void xcd_barrier_complete(unsigned* bar, unsigned x, unsigned& nloc, unsigned& nx) {
    const unsigned G = gridDim.x * gridDim.y * gridDim.z;
    unsigned sum, cnt, mine, sp = 0u;
    for (;;) {
        sum = 0u; cnt = 0u; mine = 0u;
#pragma unroll
        for (unsigned j = 0; j < 16; ++j) { const unsigned c = xb_ld(&bar[XB_XCNT(j)]); sum += c; cnt += (c > 0u) ? 1u : 0u; mine = (j == x) ? c : mine; }
        if (sum == G) break;
        __builtin_amdgcn_s_sleep(1);
        if ((++sp & 255u) == 0u) { if (xb_ld(&bar[XB_TMO])) break; if (sp > XB_SPIN_CAP) { atomicAdd(&bar[XB_TMO], 1u); break; } }
    }
    nloc = mine > 0u ? mine : 1u; nx = cnt > 0u ? cnt : 1u;
}

__device__ __forceinline__ void xcd_barrier(const XcdBarrier& b) {
    asm volatile("s_waitcnt vmcnt(0)" ::: "memory");
    __syncthreads();
    if (threadIdx.x == 0) {
        unsigned* bar = b.bar;
        __builtin_amdgcn_s_waitcnt(0);
        unsigned nloc = b.st[0], nx = b.st[1];
        if (nloc == 0u) { xcd_barrier_complete(bar, b.x, nloc, nx); b.st[0] = nloc; b.st[1] = nx; }
        const unsigned old = xb_add(&bar[XB_XSUB(b.x)], 1u);
        const unsigned gen = old / nloc;
        if (old + 1u == (gen + 1u) * nloc) {
            __builtin_amdgcn_fence(__ATOMIC_RELEASE, "agent");
            asm volatile("s_waitcnt vmcnt(0)" ::: "memory");
            const unsigned og = xb_add(&bar[XB_TOP], 1u);
            const unsigned tg = og / nx;
            if (og + 1u == (tg + 1u) * nx) xb_add(&bar[XB_TOPGEN], 1u);
            else XB_SPIN(xb_ld(&bar[XB_TOPGEN]) == tg, bar);
            __builtin_amdgcn_fence(__ATOMIC_ACQUIRE, "agent");
            xb_add(&bar[XB_XGEN(b.x)], 1u);
            asm volatile("s_waitcnt vmcnt(0)" ::: "memory");
        } else {
            XB_SPIN(xb_ld(&bar[XB_XGEN(b.x)]) == gen, bar);
            __builtin_amdgcn_fence(__ATOMIC_ACQUIRE, "agent");
            asm volatile("s_waitcnt vmcnt(0)" ::: "memory");
        }
    }
    __syncthreads();
}
__device__ __forceinline__ float wave_sum(float v) {
#pragma unroll
    for (int o = 1; o < 64; o <<= 1) v += __shfl_xor(v, o);
    return v;
}
__device__ __forceinline__ void p0_transpose_item(const float* W, int ldw, int K, int Ncols, bf16* WT, LAS float* scr, int item, int lane) {
    const int nblk = Ncols / 32, kb = item / nblk, nb = item % nblk, k0 = 64 * kb, n0 = 32 * nb;
#pragma unroll 8
    for (int i = 0; i < 32; ++i) { const int kk = 2 * i + (lane >> 5); scr[kk * 33 + (lane & 31)] = W[(size_t)(k0 + kk) * ldw + n0 + (lane & 31)]; }
    LDS_WAIT(); asm volatile("" ::: "memory");
    const int c = lane & 7;
#pragma unroll
    for (int j = 0; j < 4; ++j) { const int n = (lane >> 3) + 8 * j; const LAS float* s = scr + (8 * c) * 33 + n;
        v4u o; o.x = pk2(s[0 * 33], s[1 * 33]); o.y = pk2(s[2 * 33], s[3 * 33]); o.z = pk2(s[4 * 33], s[5 * 33]); o.w = pk2(s[6 * 33], s[7 * 33]);
        *(GAS v4u*)(WT + (size_t)(n0 + n) * K + k0 + 8 * c) = o; }
    LDS_WAIT(); asm volatile("" ::: "memory");
}
__device__ __forceinline__ float log_sigmoid(float z) { return fminf(z, 0.f) - log1pf(expf(-fabsf(z))); }

__device__ __forceinline__ void post_norm_rows(const bf16* Y, const float* xin, float* xout, const float* gpost, bf16* XN, const float* gnext, int gw, int NGW, int lane) {
    f32x4 gp[4], gn[4];
#pragma unroll
    for (int j = 0; j < 4; ++j) { gp[j] = ((const f32x4*)gpost)[lane + 64 * j]; gn[j] = gnext ? ((const f32x4*)gnext)[lane + 64 * j] : (f32x4){0.f, 0.f, 0.f, 0.f}; }
    for (int m = gw; m < M; m += NGW) {
        const unsigned long long* yr = (const unsigned long long*)(Y + (size_t)m * D) + lane; const f32x4* xr = (const f32x4*)(xin + (size_t)m * D) + lane;
        f32x4 y[4], xv[4]; float ss = 0.f;
#pragma unroll
        for (int j = 0; j < 4; ++j) { const unsigned long long w = yr[64 * j]; const unsigned lo = (unsigned)w, hi = (unsigned)(w >> 32);
            y[j] = (f32x4){__uint_as_float(lo << 16), __uint_as_float(lo & 0xffff0000u), __uint_as_float(hi << 16), __uint_as_float(hi & 0xffff0000u)}; xv[j] = xr[64 * j];
            ss += (y[j].x * y[j].x + y[j].y * y[j].y) + (y[j].z * y[j].z + y[j].w * y[j].w); }
        const float r = 1.0f / sqrtf(wave_sum(ss) * (1.0f / D) + EPS); float s2 = 0.f;
#pragma unroll
        for (int j = 0; j < 4; ++j) { xv[j] = xv[j] + y[j] * r * gp[j]; s2 += (xv[j].x * xv[j].x + xv[j].y * xv[j].y) + (xv[j].z * xv[j].z + xv[j].w * xv[j].w);
            ((f32x4*)(xout + (size_t)m * D))[lane + 64 * j] = xv[j]; }
        if (XN) { const float r2 = 1.0f / sqrtf(wave_sum(s2) * (1.0f / D) + EPS); unsigned long long* o8 = (unsigned long long*)(XN + (size_t)m * D) + lane;
#pragma unroll
            for (int j = 0; j < 4; ++j) { const f32x4 h = xv[j] * r2 * gn[j]; o8[64 * j] = (unsigned long long)pk2(h.x, h.y) | ((unsigned long long)pk2(h.z, h.w) << 32); } }
    }
}
struct Args { const float* in[27]; float* out; unsigned char* ws; };
__device__ __forceinline__ const void* kparg(int i) { const void* const __attribute__((address_space(4)))* ka = (const void* const __attribute__((address_space(4)))*)__builtin_amdgcn_kernarg_segment_ptr(); int off = i; asm volatile("" : "+s"(off)); return ka[off]; }
#define INP(i) ((const float*)kparg(i))
#define WSB() ((unsigned char*)kparg(28))
#define OUTP() ((float*)kparg(27))
#define GRID_BAR() do { XcdBarrier b_; b_.bar = (unsigned*)(WSB() + WS_CTL) + CW_BAR; b_.x = xb_xcc_id(); b_.st = (volatile LAS unsigned*)(lds + MISC_OFF) + 8; xcd_barrier(b_); } while (0)
#define P_WinE_t ((bf16*)(WSB() + WS_WINE))
#define P_WoutE_t ((bf16*)(WSB() + WS_WOUTE))
#define P_Wglu_t ((bf16*)(WSB() + WS_WGLU))
#define P_PoolB ((bf16*)(WSB() + WS_POOLB))
#define P_WsA ((bf16*)(WSB() + WS_WSA))
#define P_WinO_t ((bf16*)(WSB() + WS_WINO))
#define P_WoutO_t ((bf16*)(WSB() + WS_WOUTO))
#define P_W1_t ((bf16*)(WSB() + WS_W1))
#define P_W2_t ((bf16*)(WSB() + WS_W2))
#define P_S5W1 ((bf16*)(WSB() + WS_S5W1))
#define P_Toep ((bf16*)(WSB() + WS_TOEP))
#define P_XN ((bf16*)(WSB() + WS_XN))
#define P_Y ((bf16*)(WSB() + WS_Y))
#define P_GY ((bf16*)(WSB() + WS_GY))
#define P_H ((bf16*)(WSB() + WS_H))
#define P_U ((bf16*)(WSB() + WS_U))
#define P_Q ((bf16*)(WSB() + WS_Q))
#define P_MIX ((bf16*)(WSB() + WS_MIX))
#define P_XC ((bf16*)(WSB() + WS_XC))
#define P_POOLED ((bf16*)(WSB() + WS_POOLED))
#define P_ASGU ((bf16*)(WSB() + WS_ASGU))
#define P_Fp ((float*)(WSB() + WS_F))
#define P_FL ((float*)(WSB() + WS_FL))
#define P_Sbuf ((float*)(WSB() + WS_S))
#define GEMM_CALL(EPI, SCHED, ALIGN) pg8::gemm_phase<EPI, SCHED, ALIGN, true>(lds + RING_OFF, g, S, E)

__global__ void __launch_bounds__(NWAVES * 64, 2) mega_fwd(Args args) {
    extern __shared__ __attribute__((aligned(16))) unsigned char lds_raw[];
    LAS unsigned char* lds = (LAS unsigned char*)lds_raw;
#define PHASE_IDS int tid = threadIdx.x; asm volatile("" : "+v"(tid)); const int lane = tid & 63, wave = __builtin_amdgcn_readfirstlane(tid >> 6); const int G = gridDim.x, bx = blockIdx.x; const int gw = bx * NWAVES + wave, NGW = G * NWAVES; (void)lane; (void)wave; (void)gw; (void)NGW; (void)G; (void)bx;
    { PHASE_IDS for (int u = tid; u < (LDS_BYTES - LDSCTL_OFF) / 4; u += NWAVES * 64) ((LAS unsigned*)(lds + LDSCTL_OFF))[u] = 0u; }
    __syncthreads();
    (void)xcd_barrier_post((unsigned*)(WSB() + WS_CTL) + CW_BAR, (volatile LAS unsigned*)(lds + MISC_OFF) + 8);

    {   PHASE_IDS
    {
        const float* lam_re = INP(6); const float* lam_im = INP(7); const float* log_dt = INP(8); const float* b_re = INP(9); const float* b_im = INP(10);
        const float* c_re = INP(11); const float* c_im = INP(12); const float* dskip = INP(13);
        bf16* const Toep_ = P_Toep; bf16* const S5W1_ = P_S5W1;
        LAS float* sm = (LAS float*)lds;
        LAS float* apre = sm; LAS float* apim = sm + 17 * 64; LAS float* qre = sm + 34 * 64; LAS float* qim = qre + 64; LAS float* bbre = qim + 64; LAS float* bbim = bbre + 1024;
        for (int it = bx; it < 512; it += G) {
            const int g = it >> 4, t = it & 15;
            __syncthreads();
            if (tid < 64) {
                const int p = tid; const float lr = lam_re[g * 64 + p], li = lam_im[g * 64 + p], dt = expf(log_dt[g]); const float ang = li * dt, lg = lr * dt;
                for (int tau = 0; tau <= 16; ++tau) { const float mag = expf(lg * (float)tau); float rev = ang * (float)tau * 0.15915494309189535f; rev -= rintf(rev);
                    apre[tau * 64 + p] = mag * __builtin_amdgcn_cosf(rev); apim[tau * 64 + p] = mag * __builtin_amdgcn_sinf(rev); }
                const float nr = apre[64 + p] - 1.0f, ni = apim[64 + p], den = lr * lr + li * li;
                qre[p] = (nr * lr + ni * li) / den; qim[p] = (ni * lr - nr * li) / den;
            }
            __syncthreads();
            for (int idx = tid; idx < 1024; idx += NWAVES * 64) { const int p = idx >> 4; const float br = b_re[(size_t)g * 1024 + idx], bi = b_im[(size_t)g * 1024 + idx];
                bbre[idx] = qre[p] * br - qim[p] * bi; bbim[idx] = qre[p] * bi + qim[p] * br; }
            __syncthreads();
            for (int o = tid; o < 16 * 384; o += NWAVES * 64) {
                const int h = o / 384, k = o - h * 384; float val = 0.f; const float* cr_ = c_re + (size_t)(g * 16 + h) * 64; const float* ci_ = c_im + (size_t)(g * 16 + h) * 64;
                if (k < 256) { const int s = k >> 4, hp = k & 15;
                    if (s <= t) { const int tau = t - s; float a = 0.f;
                        for (int p = 0; p < 64; ++p) { const float cr = cr_[p], ci = ci_[p], ar = apre[tau * 64 + p], ai = apim[tau * 64 + p];
                            const float car = cr * ar - ci * ai, cai = cr * ai + ci * ar; a += car * bbre[p * 16 + hp] - cai * bbim[p * 16 + hp]; }
                        if (tau == 0 && h == hp) a += dskip[g * 16 + h];
                        val = a; } }
                else if (k < 320) { const int p = k - 256; val = cr_[p] * apre[(t + 1) * 64 + p] - ci_[p] * apim[(t + 1) * 64 + p]; }
                else { const int p = k - 320; val = -(cr_[p] * apim[(t + 1) * 64 + p] + ci_[p] * apre[(t + 1) * 64 + p]); }
                Toep_[((size_t)g * 256 + t * 16 + h) * 384 + k] = (bf16)f2bf(val);
            }
            for (int o = tid; o < 4096; o += NWAVES * 64) {
                const int pp = o >> 4, h = o & 15; float val = 0.f;
                if (pp < 128) { const int p = pp & 63; const float ar = apre[(15 - t) * 64 + p], ai = apim[(15 - t) * 64 + p], br = bbre[p * 16 + h], bi = bbim[p * 16 + h];
                    val = (pp < 64) ? (ar * br - ai * bi) : (ar * bi + ai * br); }
                S5W1_[((size_t)g * 256 + pp) * 256 + t * 16 + h] = (bf16)f2bf(val);
            }
        }
        __syncthreads();
        {
            const float* pool_w = INP(18); const float* w_s = INP(22); bf16* const PoolB_ = P_PoolB; bf16* const WsA_ = P_WsA;
            for (int idx = bx * (NWAVES * 64) + tid; idx < 2 * 65536; idx += G * NWAVES * 64) {
                const int pq = idx >> 16, r = (idx >> 8) & 255, k = idx & 255, gl = r >> 7, rr = r & 127, gl2 = k >> 7, kk = k & 127;
                const float pv = (gl == gl2) ? pool_w[((size_t)(2 * pq + gl) * 128 + kk) * 128 + rr] : 0.f;
                const float sv = (gl == gl2 && kk <= rr) ? w_s[((size_t)(2 * pq + gl) * 128 + rr) * 128 + kk] : 0.f;
                PoolB_[idx] = (bf16)f2bf(pv); WsA_[idx] = (bf16)f2bf(sv);
            }
        }
        LAS float* Wfl = (LAS float*)(lds + 98304);
        { const float* wie = INP(5); for (int idx = tid; idx < 8192; idx += NWAVES * 64) { const int k = idx >> 3, j = idx & 7; Wfl[j * 1024 + k] = wie[(size_t)k * 2056 + 2048 + j]; } }
        __syncthreads();
        {
            const float* x = INP(0); const float* gpre = INP(1); f32x4 gv[4]; bf16* const XN_ = P_XN; float* const FL_ = P_FL;
#pragma unroll
            for (int j = 0; j < 4; ++j) gv[j] = ((const f32x4*)gpre)[lane + 64 * j];
            for (int m = gw; m < M; m += NGW) {
                const f32x4* xr = (const f32x4*)(x + (size_t)m * D) + lane; f32x4 v[4]; float ss = 0.f;
#pragma unroll
                for (int j = 0; j < 4; ++j) { v[j] = xr[64 * j]; ss += (v[j].x * v[j].x + v[j].y * v[j].y) + (v[j].z * v[j].z + v[j].w * v[j].w); }
                const float r = 1.0f / sqrtf(wave_sum(ss) * (1.0f / D) + EPS);
                unsigned long long* o8 = (unsigned long long*)(XN_ + (size_t)m * D) + lane;
#pragma unroll
                for (int j = 0; j < 4; ++j) { v[j] = v[j] * r * gv[j]; o8[64 * j] = (unsigned long long)pk2(v[j].x, v[j].y) | ((unsigned long long)pk2(v[j].z, v[j].w) << 32); }
                float myfl = 0.f;
#pragma unroll
                for (int jf = 0; jf < 8; ++jf) { float a = 0.f;
#pragma unroll
                    for (int j = 0; j < 4; ++j) { const f32x4 w = ((const LAS f32x4*)(Wfl + jf * 1024))[lane + 64 * j]; a += (v[j].x * w.x + v[j].y * w.y) + (v[j].z * w.z + v[j].w * w.w); }
                    a = wave_sum(a); if (lane == jf) myfl = a; }
                if (lane < 8) FL_[(size_t)m * 8 + lane] = myfl;
            }
        }
        {
            LAS float* scr = (LAS float*)(lds + wave * 8704);
            constexpr int I_INE = 16 * 64, I_GLU = 8 * 16, I_OUT = 16 * 32, I_INO = 16 * 48, I_W1 = 16 * 128, I_W2 = 64 * 32;
            constexpr int NITEMS = I_INE + I_GLU + 2 * I_OUT + I_INO + 2 * I_W1 + 2 * I_W2;
            for (int it = gw; it < NITEMS; it += NGW) {
                int r = it;
                if (r < I_INE) { p0_transpose_item(INP(5), 2056, 1024, 2048, P_WinE_t, scr, r, lane); continue; } r -= I_INE;
                if (r < I_GLU) { p0_transpose_item(INP(14), 512, 512, 512, P_Wglu_t, scr, r, lane); continue; } r -= I_GLU;
                if (r < I_OUT) { p0_transpose_item(INP(16), 1024, 1024, 1024, P_WoutE_t, scr, r, lane); continue; } r -= I_OUT;
                if (r < I_OUT) { p0_transpose_item(INP(24), 1024, 1024, 1024, P_WoutO_t, scr, r, lane); continue; } r -= I_OUT;
                if (r < I_INO) { p0_transpose_item(INP(17), 1536, 1024, 1536, P_WinO_t, scr, r, lane); continue; } r -= I_INO;
                if (r < 2 * I_W1) { const int l = r / I_W1; p0_transpose_item(INP(25) + (size_t)l * D * FF, 4096, 1024, 4096, P_W1_t + (size_t)l * D * FF, scr, r % I_W1, lane); continue; } r -= 2 * I_W1;
                { const int l = r / I_W2; p0_transpose_item(INP(26) + (size_t)l * D * FF, 1024, 4096, 1024, P_W2_t + (size_t)l * D * FF, scr, r % I_W2, lane); }
            }
        }
    }
    }
    GRID_BAR();
    {   PHASE_IDS

            if (bx < 32) {
                const int b = bx >> 3, h = bx & 7; const float bfv = INP(15)[h]; const float* const FL_ = P_FL; float* const Fp_ = P_Fp;
                float v[8]; float run = 0.f;
#pragma unroll
                for (int j = 0; j < 8; ++j) { const int t = tid * 8 + j; run += log_sigmoid(FL_[((size_t)b * SEQ + t) * 8 + h] + bfv); v[j] = run; }
                float inc = run;
#pragma unroll
                for (int o = 1; o < 64; o <<= 1) { const float nb = __shfl_up(inc, o); if (lane >= o) inc += nb; }
                LAS float* wt = (LAS float*)lds;
                if (lane == 63) wt[wave] = inc;
                __syncthreads();
                float base = inc - run;
                for (int w = 0; w < wave; ++w) base += wt[w];
#pragma unroll
                for (int j = 0; j < 8; ++j) Fp_[(size_t)bx * SEQ + tid * 8 + j] = (base + v[j]) * 1.4426950408889634f;
                __syncthreads();
            }
            { pg8::Gemm g{P_XN, P_WinE_t, 1024, 1024, 1024}; pg8::StaticOrder S; S.init(M, 2048, G, bx, 1024, 1024); pg8::EpiInEven E{P_U, P_Q, attn_body::C2};
              GEMM_CALL(pg8::EpiInEven, pg8::StaticOrder, true); }
    }
    GRID_BAR();
    {   PHASE_IDS
            { pg8::Gemm g{P_U, P_S5W1, 384, 256, 256}; pg8::GroupOrder<0> S{128, G, bx, 256}; pg8::EpiS5P1 E{P_Sbuf};
              GEMM_CALL(pg8::EpiS5P1, pg8::GroupOrder<0>, true); }
    }
    GRID_BAR();
    {   PHASE_IDS
            if (bx < 128 && wave == 0) {
                const int b = bx >> 5, g = bx & 31, p = lane;
                const float lr = INP(6)[g * 64 + p], li = INP(7)[g * 64 + p], dt = expf(INP(8)[g]);
                const float mag = expf(lr * dt * 16.0f); float rev = (li * dt) * 16.0f * 0.15915494309189535f; rev -= rintf(rev);
                const float ar = mag * __builtin_amdgcn_cosf(rev), ai = mag * __builtin_amdgcn_sinf(rev);
                float xr = 0.f, xi = 0.f;
                const float* Sp = P_Sbuf + (size_t)(g * 1024 + b * 256) * 128; bf16* Up = P_U + (size_t)(g * 1024 + b * 256) * 384 + 256;
                for (int c = 0; c < 256; c += 8) {
                    float sr[8], si[8];
#pragma unroll
                    for (int k = 0; k < 8; ++k) { sr[k] = Sp[(size_t)(c + k) * 128 + p]; si[k] = Sp[(size_t)(c + k) * 128 + 64 + p]; }
#pragma unroll
                    for (int k = 0; k < 8; ++k) { Up[(size_t)(c + k) * 384 + p] = (bf16)f2bf(xr); Up[(size_t)(c + k) * 384 + 64 + p] = (bf16)f2bf(xi);
                        const float nr = ar * xr - ai * xi + sr[k], ni = ar * xi + ai * xr + si[k]; xr = nr; xi = ni; }
                }
            }
    }
    GRID_BAR();
    {   PHASE_IDS
            { pg8::Gemm g{P_U, P_Toep, 384, 384, 384}; pg8::GroupOrder<0> S{128, G, bx, 384}; pg8::EpiS5P2 E{P_GY};
              GEMM_CALL(pg8::EpiS5P2, pg8::GroupOrder<0>, true); }
    }
    GRID_BAR();
    {   PHASE_IDS
            { pg8::Gemm g{P_GY, P_Wglu_t, 512, 512, 512}; pg8::GroupOrder<1> S{128, G, bx, 0}; pg8::EpiGLU E{P_GY, P_MIX};
              GEMM_CALL(pg8::EpiGLU, pg8::GroupOrder<1>, true); }
            { const attn_body::AttnTensors AT{(const attn_body::bf16*)P_Q, (const attn_body::bf16*)(P_Q + (size_t)M * 512), (const attn_body::bf16*)(P_Q + (size_t)2 * M * 512), (attn_body::bf16*)(P_MIX + 512), P_Fp};
              const attn_body::StaticOrder S(G, bx);
              attn_body::attn_phase<attn_body::StaticOrder>((char*)lds_raw + RING_OFF, AT, S); }
    }
    GRID_BAR();
    {   PHASE_IDS
        { pg8::Gemm g{P_MIX, 0 == 0 ? P_WoutE_t : P_WoutO_t, 1024, 1024, 1024}; pg8::StaticOrder S; S.init(M, 1024, G, bx, 1024, 1024); pg8::EpiBf16<0> E{P_Y, 1024};
          GEMM_CALL(pg8::EpiBf16<0>, pg8::StaticOrder, true); }
    }
    GRID_BAR();
    {   PHASE_IDS
        post_norm_rows(P_Y, 0 == 0 ? INP(0) : OUTP(), OUTP(), INP(2) + 0 * D, P_XN, INP(3) + 0 * D, gw, NGW, lane);
    }
    GRID_BAR();
    {   PHASE_IDS
        { pg8::Gemm g{P_XN, P_W1_t + (size_t)0 * D * FF, 1024, 1024, 1024}; pg8::StaticOrder S; S.init(M, FF, G, bx, 1024, 1024); pg8::EpiBf16<1> E{P_H, FF};
          GEMM_CALL(pg8::EpiBf16<1>, pg8::StaticOrder, true); }
    }
    GRID_BAR();
    {   PHASE_IDS
        { pg8::Gemm g{P_H, P_W2_t + (size_t)0 * D * FF, FF, FF, FF}; pg8::StaticOrder S; S.init(M, 1024, G, bx, FF, FF); pg8::EpiBf16<0> E{P_Y, 1024};
          GEMM_CALL(pg8::EpiBf16<0>, pg8::StaticOrder, true); }
    }
    GRID_BAR();
    {   PHASE_IDS
        post_norm_rows(P_Y, OUTP(), OUTP(), INP(4) + 0 * D, 0 == 0 ? P_XN : (bf16*)nullptr, 0 == 0 ? INP(1) + D : (const float*)nullptr, gw, NGW, lane);
    }
    GRID_BAR();
    {   PHASE_IDS
            { pg8::Gemm g{P_XN, P_WinO_t, 1024, 1024, 1024}; pg8::StaticOrder S; S.init(M, 1536, G, bx, 1024, 1024); pg8::EpiInOdd E{P_XC};
              GEMM_CALL(pg8::EpiInOdd, pg8::StaticOrder, true); }
    }
    GRID_BAR();
    {   PHASE_IDS
            {
                const bf16* const XC_ = P_XC; const bf16* GV = XC_ + (size_t)2 * M * 512; bf16* const POOLED_ = P_POOLED; bf16* const ASGU_ = P_ASGU;
                for (int it = bx * (NWAVES * 64) + tid; it < M * 64; it += G * NWAVES * 64) {
                    const int m = it >> 6, c8 = (it & 63) * 8, t = m & (SEQ - 1), g = c8 >> 7, w = 2 << g, cnt = (t + 1 < w) ? t + 1 : w;
                    float a[8]; v4u cur = (v4u){0u, 0u, 0u, 0u};
#pragma unroll
                    for (int e = 0; e < 8; ++e) a[e] = 0.f;
                    for (int j = 0; j < cnt; ++j) { const v4u v = *(const v4u*)(XC_ + (size_t)(m - j) * 512 + c8); if (j == 0) cur = v;
                        a[0] += pg8::bflo(v.x); a[1] += pg8::bfhi(v.x); a[2] += pg8::bflo(v.y); a[3] += pg8::bfhi(v.y); a[4] += pg8::bflo(v.z); a[5] += pg8::bfhi(v.z); a[6] += pg8::bflo(v.w); a[7] += pg8::bfhi(v.w); }
                    const float inv = 1.0f / (float)cnt; v4u o;
                    o.x = pk2(a[0] * inv - pg8::bflo(cur.x), a[1] * inv - pg8::bfhi(cur.x)); o.y = pk2(a[2] * inv - pg8::bflo(cur.y), a[3] * inv - pg8::bfhi(cur.y));
                    o.z = pk2(a[4] * inv - pg8::bflo(cur.z), a[5] * inv - pg8::bfhi(cur.z)); o.w = pk2(a[6] * inv - pg8::bflo(cur.w), a[7] * inv - pg8::bfhi(cur.w));
                    *(v4u*)(POOLED_ + (size_t)m * 512 + c8) = o;
                }
                const float* ln_g = INP(20); const float* ln_b = INP(21);
                LAS unsigned short* T = (LAS unsigned short*)lds;
                for (int it = bx; it < 256; it += G) {
                    const int cn = it >> 1, hf = it & 1; float lg[4], lb[4];
#pragma unroll
                    for (int i = 0; i < 4; ++i) { lg[i] = ln_g[hf * 256 + lane + 64 * i]; lb[i] = ln_b[hf * 256 + lane + 64 * i]; }
                    __syncthreads();
                    for (int k = 0; k < 16; ++k) { const int s = wave * 16 + k; const size_t tok = (size_t)cn * 128 + s;
                        const v4u v = *(const v4u*)(GV + tok * 512 + lane * 8);
                        const float f0 = pg8::bflo(v.x), f1 = pg8::bfhi(v.x), f2 = pg8::bflo(v.y), f3 = pg8::bfhi(v.y), f4 = pg8::bflo(v.z), f5 = pg8::bfhi(v.z), f6 = pg8::bflo(v.w), f7 = pg8::bfhi(v.w);
                        const float mean = wave_sum(((f0 + f1) + (f2 + f3)) + ((f4 + f5) + (f6 + f7))) * (1.0f / 512.0f);
                        const float d0 = f0 - mean, d1 = f1 - mean, d2 = f2 - mean, d3 = f3 - mean, d4 = f4 - mean, d5 = f5 - mean, d6 = f6 - mean, d7 = f7 - mean;
                        const float var = wave_sum(((d0 * d0 + d1 * d1) + (d2 * d2 + d3 * d3)) + ((d4 * d4 + d5 * d5) + (d6 * d6 + d7 * d7))) * (1.0f / 512.0f);
                        const float rstd = 1.0f / sqrtf(var + EPS);
#pragma unroll
                        for (int i = 0; i < 4; ++i) { const int cl = lane + 64 * i; const float val = __uint_as_float((unsigned)GV[tok * 512 + hf * 256 + cl] << 16);
                            T[cl * 130 + s] = (unsigned short)f2bf((val - mean) * rstd * lg[i] + lb[i]); } }
                    __syncthreads();
                    for (int k = 0; k < 32; ++k) { const int cl = wave * 32 + k, ch = hf * 256 + cl, g = ch >> 7, c = ch & 127;
                        const unsigned v = *(const LAS unsigned*)(T + cl * 130 + 2 * lane);
                        *(unsigned*)(ASGU_ + ((size_t)(cn * 128 + c) * 512 + g * 128 + 2 * lane)) = v; }
                }
                __syncthreads();
            }
    }
    GRID_BAR();
    {   PHASE_IDS
            { pg8::Gemm g{P_POOLED, P_PoolB, 512, 256, 256}; pg8::GroupOrder<2> S{128, G, bx, 0}; pg8::EpiPool E{INP(19), P_MIX};
              GEMM_CALL(pg8::EpiPool, pg8::GroupOrder<2>, true); }
            { pg8::Gemm g{P_WsA, P_ASGU, 256, 512, 256}; pg8::GroupOrder<3> S{128, G, bx - 128, 0}; pg8::EpiSGU E{INP(23), P_XC + (size_t)M * 512, P_MIX};
              GEMM_CALL(pg8::EpiSGU, pg8::GroupOrder<3>, true); }
    }
    GRID_BAR();
    {   PHASE_IDS
        { pg8::Gemm g{P_MIX, 1 == 0 ? P_WoutE_t : P_WoutO_t, 1024, 1024, 1024}; pg8::StaticOrder S; S.init(M, 1024, G, bx, 1024, 1024); pg8::EpiBf16<0> E{P_Y, 1024};
          GEMM_CALL(pg8::EpiBf16<0>, pg8::StaticOrder, true); }
    }
    GRID_BAR();
    {   PHASE_IDS
        post_norm_rows(P_Y, 1 == 0 ? INP(0) : OUTP(), OUTP(), INP(2) + 1 * D, P_XN, INP(3) + 1 * D, gw, NGW, lane);
    }
    GRID_BAR();
    {   PHASE_IDS
        { pg8::Gemm g{P_XN, P_W1_t + (size_t)1 * D * FF, 1024, 1024, 1024}; pg8::StaticOrder S; S.init(M, FF, G, bx, 1024, 1024); pg8::EpiBf16<1> E{P_H, FF};
          GEMM_CALL(pg8::EpiBf16<1>, pg8::StaticOrder, true); }
    }
    GRID_BAR();
    {   PHASE_IDS
        { pg8::Gemm g{P_H, P_W2_t + (size_t)1 * D * FF, FF, FF, FF}; pg8::StaticOrder S; S.init(M, 1024, G, bx, FF, FF); pg8::EpiBf16<0> E{P_Y, 1024};
          GEMM_CALL(pg8::EpiBf16<0>, pg8::StaticOrder, true); }
    }
    GRID_BAR();
    {   PHASE_IDS
        post_norm_rows(P_Y, OUTP(), OUTP(), INP(4) + 1 * D, 1 == 0 ? P_XN : (bf16*)nullptr, 1 == 0 ? INP(1) + D : (const float*)nullptr, gw, NGW, lane);

    }
}

extern "C" void kernel_launch(void* const* d_in, const int* in_sizes, int n_in, void* d_out, int out_size, void* d_ws, size_t ws_size, hipStream_t stream) {
    static int grid = 0;
    if (grid == 0) {
        if (n_in != 27 || out_size != M * D || ws_size < WS_END) { fprintf(stderr, "kernel_launch: unexpected shapes (n_in %d, out %d, ws %zu); nothing launched\n", n_in, out_size, ws_size); grid = -1; return; }
        int dev = 0, cus = 0;
        if (hipGetDevice(&dev) != hipSuccess || hipDeviceGetAttribute(&cus, hipDeviceAttributeMultiprocessorCount, dev) != hipSuccess) { grid = -1; return; }
        if (hipFuncSetAttribute((const void*)mega_fwd, hipFuncAttributeMaxDynamicSharedMemorySize, LDS_BYTES) != hipSuccess) { fprintf(stderr, "kernel_launch: hipFuncSetAttribute failed\n"); grid = -1; return; }
        if (cus < 256) { fprintf(stderr, "kernel_launch: needs 256 CUs (one resident workgroup each), device has %d; nothing launched\n", cus); grid = -1; return; }
        grid = 256;
    }
    if (grid < 0) return;
    if (hipMemsetAsync((char*)d_ws + WS_CTL, 0, CTL_ZERO_BYTES, stream) != hipSuccess) return;
    Args a{};
    for (int i = 0; i < 27; ++i) a.in[i] = (const float*)d_in[i];
    a.out = (float*)d_out; a.ws = (unsigned char*)d_ws;
    hipLaunchKernelGGL(mega_fwd, dim3(grid), dim3(NWAVES * 64), LDS_BYTES, stream, a);
}
```
